# Optimizing an MI355X kernel written in HIP

```python
import math
import jax, jax.numpy as jnp
from jax import lax
import numpy as np

D_MODEL = 1024
BATCH = 8
SEQ = 2048
DEPTH = 2

CHUNK = 64
N_MIXERS = 2
N_ATTN_LAYERS = (DEPTH + 1) // 2
N_GMLP_LAYERS = DEPTH // 2

N_HEADS = 8
HEAD_DIM_QK = D_MODEL // (2 * N_HEADS)
HEAD_DIM_V = 2 * HEAD_DIM_QK
QK_WIDTH = N_HEADS * 2 * HEAD_DIM_QK
V_WIDTH = N_HEADS * HEAD_DIM_V
Q_BLOCK = 128

GMLP_BLOCK = 128
GMLP_HALF = 2 * D_MODEL
GMLP_GROUPS = 8
GMLP_GROUP_DIM = GMLP_HALF // GMLP_GROUPS

D_FF = -(-8 * D_MODEL // (3 * 256)) * 256

DEEPNORM_ALPHA = (2 * DEPTH) ** 0.25
DEEPNORM_BETA = (8 * DEPTH) ** -0.25
LN_EPS = 1e-5
MASK_VALUE = -1e30

kernel_name = "hybrid_diffattn_gmlp_deepnorm"


def _layernorm(x, g, b):
    xf = x.astype(jnp.float32)
    mu = jnp.mean(xf, axis=-1, keepdims=True)
    var = jnp.mean(jnp.square(xf - mu), axis=-1, keepdims=True)
    y = (xf - mu) * lax.rsqrt(var + LN_EPS) * g.astype(jnp.float32) + b.astype(jnp.float32)
    return y.astype(x.dtype)


def _rmsnorm(x, g):
    xf = x.astype(jnp.float32)
    y = xf * lax.rsqrt(jnp.mean(jnp.square(xf), axis=-1, keepdims=True) + LN_EPS) * g.astype(jnp.float32)
    return y.astype(x.dtype)


def _lambda_init(layer_idx):
    return 0.8 - 0.6 * math.exp(-0.3 * layer_idx)


def _diff_attention(h, w_qkv, lq1, lk1, lq2, lk2, g_sub, w_o, lambda_init, slopes, pos):
    B, S, _ = h.shape
    qkv = h @ w_qkv
    q, k, v = jnp.split(qkv, [QK_WIDTH, 2 * QK_WIDTH], axis=-1)
    q = q.reshape(B, S, N_HEADS, 2, HEAD_DIM_QK)
    k = k.reshape(B, S, N_HEADS, 2, HEAD_DIM_QK)
    v = v.reshape(B, S, N_HEADS, HEAD_DIM_V)
    lam = (jnp.exp(jnp.sum(lq1.astype(jnp.float32) * lk1.astype(jnp.float32)))
           - jnp.exp(jnp.sum(lq2.astype(jnp.float32) * lk2.astype(jnp.float32)))
           + lambda_init)
    scale = HEAD_DIM_QK ** -0.5
    n_blk = S // Q_BLOCK
    q_blocks = q.reshape(B, n_blk, Q_BLOCK, N_HEADS, 2, HEAD_DIM_QK).transpose(1, 0, 2, 3, 4, 5)
    qpos_blocks = pos.reshape(n_blk, Q_BLOCK)
    k_chunk = pos // CHUNK

    def one_block(args):
        q_blk, qpos = args
        s = jnp.einsum('bqhcd,bkhcd->bhcqk', q_blk, k).astype(jnp.float32) * scale
        dist = jnp.abs(qpos[:, None] - pos[None, :]).astype(jnp.float32)
        s = s - slopes[None, :, None, None, None] * dist[None, None, None]
        allowed = k_chunk[None, :] <= (qpos // CHUNK)[:, None]
        s = jnp.where(allowed[None, None, None], s, MASK_VALUE)
        p = jax.nn.softmax(s, axis=-1)
        a = (p[:, :, 0] - lam * p[:, :, 1]).astype(v.dtype)
        return jnp.einsum('bhqk,bkhd->bqhd', a, v)

    o = lax.map(one_block, (q_blocks, qpos_blocks))
    o = o.transpose(1, 0, 2, 3, 4).reshape(B, S, N_HEADS, HEAD_DIM_V)
    o = _rmsnorm(o, g_sub) * (1.0 - lambda_init)
    return o.reshape(B, S, V_WIDTH) @ w_o


def _gmlp_spatial_gating(h, w_in, b_in, ln_g, ln_b, w_s, b_s, w_out):
    B, S, _ = h.shape
    z = jax.nn.gelu(h @ w_in + b_in, approximate=False)
    u, v = jnp.split(z, 2, axis=-1)
    v = _layernorm(v, ln_g, ln_b)
    v = v.reshape(B, S // GMLP_BLOCK, GMLP_BLOCK, GMLP_GROUPS, GMLP_GROUP_DIM)
    tri = jnp.tril(jnp.ones((GMLP_BLOCK, GMLP_BLOCK), dtype=w_s.dtype))
    v = jnp.einsum('gts,bnsgc->bntgc', w_s * tri[None], v) + b_s.T[None, None, :, :, None]
    y = u * v.reshape(B, S, GMLP_HALF)
    return y @ w_out


def _swiglu(h, w_gate, w_up, w_down):
    return (jax.nn.silu(h @ w_gate) * (h @ w_up)) @ w_down


def setup_inputs(seed: int = 0) -> dict:
    key = jax.random.key(seed)
    ks = jax.random.split(key, 24)
    f32 = jnp.float32

    def nrm(k, shape, scale):
        return jax.random.normal(k, shape, dtype=f32) * scale

    x = nrm(ks[0], (BATCH, SEQ, D_MODEL), 1.0)
    w_qk = nrm(ks[1], (N_ATTN_LAYERS, D_MODEL, 2 * QK_WIDTH), D_MODEL ** -0.5)
    w_v = nrm(ks[2], (N_ATTN_LAYERS, D_MODEL, V_WIDTH), D_MODEL ** -0.5 * DEEPNORM_BETA)
    attn_w_qkv = jnp.concatenate([w_qk, w_v], axis=-1)
    attn_lambda_q1 = nrm(ks[3], (N_ATTN_LAYERS, HEAD_DIM_QK), 0.1)
    attn_lambda_k1 = nrm(ks[4], (N_ATTN_LAYERS, HEAD_DIM_QK), 0.1)
    attn_lambda_q2 = nrm(ks[5], (N_ATTN_LAYERS, HEAD_DIM_QK), 0.1)
    attn_lambda_k2 = nrm(ks[6], (N_ATTN_LAYERS, HEAD_DIM_QK), 0.1)
    attn_subln_g = 1.0 + nrm(ks[7], (N_ATTN_LAYERS, HEAD_DIM_V), 0.02)
    attn_w_o = nrm(ks[8], (N_ATTN_LAYERS, V_WIDTH, D_MODEL), V_WIDTH ** -0.5 * DEEPNORM_BETA)

    gmlp_w_in = nrm(ks[9], (N_GMLP_LAYERS, D_MODEL, 2 * GMLP_HALF), D_MODEL ** -0.5)
    gmlp_b_in = nrm(ks[10], (N_GMLP_LAYERS, 2 * GMLP_HALF), 0.01)
    gmlp_ln_g = 1.0 + nrm(ks[11], (N_GMLP_LAYERS, GMLP_HALF), 0.02)
    gmlp_ln_b = nrm(ks[12], (N_GMLP_LAYERS, GMLP_HALF), 0.01)
    gmlp_w_s = nrm(ks[13], (N_GMLP_LAYERS, GMLP_GROUPS, GMLP_BLOCK, GMLP_BLOCK), GMLP_BLOCK ** -0.5)
    gmlp_b_s = 1.0 + nrm(ks[14], (N_GMLP_LAYERS, GMLP_GROUPS, GMLP_BLOCK), 0.01)
    gmlp_w_out = nrm(ks[15], (N_GMLP_LAYERS, GMLP_HALF, D_MODEL), GMLP_HALF ** -0.5 * DEEPNORM_BETA)

    ln_mix_g = 1.0 + nrm(ks[16], (DEPTH, D_MODEL), 0.02)
    ln_mix_b = nrm(ks[17], (DEPTH, D_MODEL), 0.01)
    ffn_w_gate = nrm(ks[18], (DEPTH, D_MODEL, D_FF), D_MODEL ** -0.5)
    ffn_w_up = nrm(ks[19], (DEPTH, D_MODEL, D_FF), D_MODEL ** -0.5 * DEEPNORM_BETA)
    ffn_w_down = nrm(ks[20], (DEPTH, D_FF, D_MODEL), D_FF ** -0.5 * DEEPNORM_BETA)
    ln_ffn_g = 1.0 + nrm(ks[21], (DEPTH, D_MODEL), 0.02)
    ln_ffn_b = nrm(ks[22], (DEPTH, D_MODEL), 0.01)
    return {
        "x": x,
        "attn_w_qkv": attn_w_qkv,
        "attn_lambda_q1": attn_lambda_q1,
        "attn_lambda_k1": attn_lambda_k1,
        "attn_lambda_q2": attn_lambda_q2,
        "attn_lambda_k2": attn_lambda_k2,
        "attn_subln_g": attn_subln_g,
        "attn_w_o": attn_w_o,
        "gmlp_w_in": gmlp_w_in,
        "gmlp_b_in": gmlp_b_in,
        "gmlp_ln_g": gmlp_ln_g,
        "gmlp_ln_b": gmlp_ln_b,
        "gmlp_w_s": gmlp_w_s,
        "gmlp_b_s": gmlp_b_s,
        "gmlp_w_out": gmlp_w_out,
        "ln_mix_g": ln_mix_g,
        "ln_mix_b": ln_mix_b,
        "ffn_w_gate": ffn_w_gate,
        "ffn_w_up": ffn_w_up,
        "ffn_w_down": ffn_w_down,
        "ln_ffn_g": ln_ffn_g,
        "ln_ffn_b": ln_ffn_b,
    }


def reference(x, attn_w_qkv, attn_lambda_q1, attn_lambda_k1, attn_lambda_q2, attn_lambda_k2,
              attn_subln_g, attn_w_o, gmlp_w_in, gmlp_b_in, gmlp_ln_g, gmlp_ln_b, gmlp_w_s,
              gmlp_b_s, gmlp_w_out, ln_mix_g, ln_mix_b, ffn_w_gate, ffn_w_up, ffn_w_down,
              ln_ffn_g, ln_ffn_b):
    S = x.shape[1]
    pos = jnp.arange(S, dtype=jnp.int32)
    slopes = 2.0 ** (-8.0 * jnp.arange(1, N_HEADS + 1, dtype=jnp.float32) / N_HEADS)
    for i in range(DEPTH):
        j = i // N_MIXERS
        if i % N_MIXERS == 0:
            mix = _diff_attention(x, attn_w_qkv[j], attn_lambda_q1[j], attn_lambda_k1[j],
                                  attn_lambda_q2[j], attn_lambda_k2[j], attn_subln_g[j],
                                  attn_w_o[j], _lambda_init(i), slopes, pos)
        else:
            mix = _gmlp_spatial_gating(x, gmlp_w_in[j], gmlp_b_in[j], gmlp_ln_g[j], gmlp_ln_b[j],
                                       gmlp_w_s[j], gmlp_b_s[j], gmlp_w_out[j])
        x = _layernorm(DEEPNORM_ALPHA * x + mix, ln_mix_g[i], ln_mix_b[i])
        x = _layernorm(DEEPNORM_ALPHA * x + _swiglu(x, ffn_w_gate[i], ffn_w_up[i], ffn_w_down[i]),
                       ln_ffn_g[i], ln_ffn_b[i])
    return x
```

```cpp
#include <hip/hip_runtime.h>
#include <cstdio>
#include <cstdint>
namespace pg8 {
#define PG8_LAS __attribute__((address_space(3)))
typedef unsigned short bf16_t;
typedef short bf16x8 __attribute__((ext_vector_type(8)));
typedef float f32x4 __attribute__((ext_vector_type(4)));
typedef unsigned u32x4 __attribute__((ext_vector_type(4)));
constexpr int BM = 256, BK = 64, HALF = 128, HTB = HALF * BK * 2  , STAGE_BYTES = 8 * HTB, NXCD = 8, WGM = 8;

__host__ __device__ __forceinline__ int lds_byte(int r, int c) { const int st = (r >> 4) * 2 + (c >> 5), rr = r & 15, cc = c & 31, ob = rr * 64 + cc * 2; return st * 1024 + (ob ^ (((ob >> 9) & 1) << 5)); }
__host__ __device__ __forceinline__ void stage_rc(int b, int& R, int& C) { const int st = b / 1024, sb = b % 1024, swz = sb ^ (((sb >> 9) & 1) << 5); R = (st >> 1) * 16 + swz / 64; C = (st & 1) * 32 + (swz % 64) / 2; }
__host__ __device__ __forceinline__ int perm32(int rho) { const int n = rho >> 4, i = rho & 15; return 8 * (i >> 2) + 4 * n + (i & 3); }

struct Unit { int pm, pn; };
struct Gemm { const bf16_t* A; const bf16_t* Bt; int M, N, K; };

struct StaticOrder {
    int nM, nN, nwg, G, c;
    __host__ __device__ void init(int M, int N, int G_, int c_) { nM = M / BM; nN = N / BM; nwg = nM * nN; G = G_; c = c_; }
    __host__ __device__ bool next(int i, Unit& u) const {
        const long L = (long)i * G + c; if (L >= nwg) return false;
        int wgid = (int)L; { const int q = nwg / NXCD, r = nwg % NXCD, xcd = wgid % NXCD, off = wgid / NXCD; wgid = (xcd < r ? xcd * (q + 1) : r * (q + 1) + (xcd - r) * q) + off; }
        const int nig = WGM * nN, gid = wgid / nig, fm = gid * WGM, gsz = (nM - fm) < WGM ? (nM - fm) : WGM;
        u.pm = fm + ((wgid % nig) % gsz); u.pn = (wgid % nig) / gsz; return true;
    }
    __device__ __forceinline__ void a_ready(const Unit&) const {}
    __device__ __forceinline__ void done(const Unit&) const {}
};

__device__ __forceinline__ unsigned cvt_pk_bf16(float lo, float hi) { unsigned r; asm volatile("v_cvt_pk_bf16_f32 %0, %1, %2" : "=v"(r) : "v"(lo), "v"(hi)); return r; }
typedef float f32x2 __attribute__((ext_vector_type(2)));
__device__ __forceinline__ f32x2 gelu_pk(f32x2 v) {
    const f32x2 av = __builtin_elementwise_abs(v), d = av * 0.2316418882f + 1.0f;
    f32x2 t; t.x = __builtin_amdgcn_rcpf(d.x); t.y = __builtin_amdgcn_rcpf(d.y);
    f32x2 q = t * 0.5307027145f + (-0.7265760135f); q = q * t + 0.7107068705f; q = q * t + (-0.142248368f); q = q * t + 0.127414796f; q = q * t;
    const f32x2 s = (v * v) * (-0.72134752044f);
    f32x2 e; e.x = __builtin_amdgcn_exp2f(s.x); e.y = __builtin_amdgcn_exp2f(s.y);
    const f32x2 m = v * (q * e), r = v - m;
    f32x2 o; o.x = v.x < 0.f ? m.x : r.x; o.y = v.y < 0.f ? m.y : r.y; return o;
}


__device__ __forceinline__ u32x4 pack8(const f32x4 v0, const f32x4 v1) { u32x4 w; w.x = cvt_pk_bf16(v0[0], v0[1]); w.y = cvt_pk_bf16(v0[2], v0[3]); w.z = cvt_pk_bf16(v1[0], v1[1]); w.w = cvt_pk_bf16(v1[2], v1[3]); return w; }
__device__ __forceinline__ f32x4 gelu4(const f32x4 v) { const f32x2 a = gelu_pk((f32x2){v[0], v[1]}), b = gelu_pk((f32x2){v[2], v[3]}); return (f32x4){a.x, a.y, b.x, b.y}; }

struct EpiScaleBf16 {
    static constexpr bool PERM = true, AFTER_DRAIN = false;
    bf16_t* O; int ldc; int npn_scaled; float scale;
    __device__ __forceinline__ void operator()(f32x4 (&acc)[2][2][4][2], const Unit& u, int wr, int wc, int fr, int fq) const {
        const int row0 = u.pm * BM + wr * 64 + fr, col0 = u.pn * BM + wc * 32 + 8 * fq;
        const float sc = (u.pn < npn_scaled) ? scale : 1.f;
#pragma unroll
        for (int ai = 0; ai < 2; ++ai)
#pragma unroll
            for (int m = 0; m < 4; ++m) { bf16_t* rowp = O + (size_t)(row0 + ai * HALF + m * 16) * ldc + col0;
#pragma unroll
                for (int bj = 0; bj < 2; ++bj) *(u32x4*)(rowp + bj * HALF) = pack8(acc[ai][bj][m][0] * sc, acc[ai][bj][m][1] * sc); }
    }
};
struct EpiGeluColBias {
    static constexpr bool PERM = true, AFTER_DRAIN = false;
    bf16_t* O; int ldc; const float* bias;
    __device__ __forceinline__ void operator()(f32x4 (&acc)[2][2][4][2], const Unit& u, int wr, int wc, int fr, int fq) const {
        const int row0 = u.pm * BM + wr * 64 + fr, col0 = u.pn * BM + wc * 32 + 8 * fq;
#pragma unroll
        for (int bj = 0; bj < 2; ++bj) { const f32x4 b0 = *(const f32x4*)(bias + col0 + bj * HALF), b1 = *(const f32x4*)(bias + col0 + bj * HALF + 4);
#pragma unroll
            for (int ai = 0; ai < 2; ++ai)
#pragma unroll
                for (int m = 0; m < 4; ++m) { bf16_t* rowp = O + (size_t)(row0 + ai * HALF + m * 16) * ldc + col0;
                    *(u32x4*)(rowp + bj * HALF) = pack8(gelu4(acc[ai][bj][m][0] + b0), gelu4(acc[ai][bj][m][1] + b1)); asm volatile("" ::: "memory"); } }
    }
};
struct EpiGeluRowBiasStats {
    static constexpr bool PERM = true, AFTER_DRAIN = false;
    bf16_t* O; int ldc; const float* bias; float* stats;
    __device__ __forceinline__ void operator()(f32x4 (&acc)[2][2][4][2], const Unit& u, int wr, int wc, int fr, int fq) const {
        const int row0 = u.pm * BM + wr * 64 + fr, col0 = u.pn * BM + wc * 32 + 8 * fq;
#pragma unroll
        for (int ai = 0; ai < 2; ++ai)
#pragma unroll
            for (int m = 0; m < 4; ++m) { const int row = row0 + ai * HALF + m * 16; const float b = bias[row]; bf16_t* rowp = O + (size_t)row * ldc + col0;
#pragma unroll
                for (int bj = 0; bj < 2; ++bj) { acc[ai][bj][m][0] = gelu4(acc[ai][bj][m][0] + b); acc[ai][bj][m][1] = gelu4(acc[ai][bj][m][1] + b);
                    *(u32x4*)(rowp + bj * HALF) = pack8(acc[ai][bj][m][0], acc[ai][bj][m][1]); asm volatile("" ::: "memory"); } }
#pragma unroll
        for (int bj = 0; bj < 2; ++bj)
#pragma unroll
            for (int n = 0; n < 2; ++n) {
                f32x4 s = (f32x4){0.f, 0.f, 0.f, 0.f}, q = (f32x4){0.f, 0.f, 0.f, 0.f};
#pragma unroll
                for (int ai = 0; ai < 2; ++ai)
#pragma unroll
                    for (int m = 0; m < 4; ++m) { const f32x4 v = acc[ai][bj][m][n]; s += v; q += v * v; }
#pragma unroll
                for (int e = 0; e < 4; ++e) {
#pragma unroll
                    for (int o = 1; o < 16; o <<= 1) { s[e] += __shfl_xor(s[e], o); q[e] += __shfl_xor(q[e], o); } }
                if (fr == 0) { float* sp = stats + 2 * (size_t)(col0 + bj * HALF + 4 * n);
#pragma unroll
                    for (int e = 0; e < 4; ++e) { atomicAdd(sp + 2 * e, s[e]); atomicAdd(sp + 2 * e + 1, q[e]); } }
                asm volatile("" ::: "memory");
            }
    }
};
struct EpiSwiglu {
    static constexpr bool PERM = true, AFTER_DRAIN = false;
    bf16_t* O; int ldc;
    __device__ __forceinline__ void operator()(f32x4 (&acc)[2][2][4][2], const Unit& u, int wr, int wc, int fr, int fq) const {
        const int row0 = u.pm * BM + wr * 64 + fr, col0 = u.pn * HALF + wc * 32 + 8 * fq;
#pragma unroll
        for (int ai = 0; ai < 2; ++ai)
#pragma unroll
            for (int m = 0; m < 4; ++m) { bf16_t* rowp = O + (size_t)(row0 + ai * HALF + m * 16) * ldc + col0; f32x4 h[2];
#pragma unroll
                for (int n = 0; n < 2; ++n) { const f32x4 g = acc[ai][0][m][n], up = acc[ai][1][m][n];
#pragma unroll
                    for (int e = 0; e < 4; ++e) { const float sg = __builtin_amdgcn_rcpf(1.f + __builtin_amdgcn_exp2f(-1.4426950408889634f * g[e])); h[n][e] = g[e] * sg * up[e]; } }
                *(u32x4*)rowp = pack8(h[0], h[1]); }
    }
};
struct EpiResF32 {
    static constexpr bool PERM = false, AFTER_DRAIN = false;
    const float* res; float* out; int ldc; float alpha;
    __device__ __forceinline__ void operator()(f32x4 (&acc)[2][2][4][2], const Unit& u, int wr, int wc, int fr, int fq) const {
        const int row0 = u.pm * BM + wr * 64 + fr, col0 = u.pn * BM + wc * 32 + 4 * fq;
#pragma unroll
        for (int ai = 0; ai < 2; ++ai)
#pragma unroll
            for (int m = 0; m < 4; ++m) { const size_t off = (size_t)(row0 + ai * HALF + m * 16) * ldc + col0;
#pragma unroll
                for (int bj = 0; bj < 2; ++bj)
#pragma unroll
                    for (int n = 0; n < 2; ++n) { const f32x4 r = *(const f32x4*)(res + off + bj * HALF + n * 16); *(f32x4*)(out + off + bj * HALF + n * 16) = r * alpha + acc[ai][bj][m][n]; } }
    }
};
template <class Epi, class Sched, bool ALIGN_EPI = false, bool SP2 = false>
__device__ __forceinline__ void gemm_phase(PG8_LAS unsigned char* lds, const Gemm g, const Sched& S, const Epi& E) {
    int tid_ = threadIdx.x; asm volatile("" : "+v"(tid_));
    const int tid = tid_, wid = __builtin_amdgcn_readfirstlane(tid >> 6), lane = tid & 63, wr = wid >> 2, wc = wid & 3, fr = lane & 15, fq = lane >> 4;
    const int K = g.K, nt = K / BK;
    unsigned voffA[2], voffB[2];
#pragma unroll
    for (int i = 0; i < 2; ++i) { int R, C; stage_rc(tid * 16 + i * 8192, R, C); const int Rb = Epi::PERM ? ((R & ~31) + perm32(R & 31)) : R;
        voffA[i] = (unsigned)(R * K + C) * 2u; voffB[i] = (unsigned)(Rb * K + C) * 2u; }
    const size_t kstep = (size_t)(BK * 2);
    const size_t hstep = (size_t)HALF * K * 2;
    const size_t tstep = 2 * hstep;
    const unsigned ldsw = (unsigned)wid * 1024u;
    const int aoff = lds_byte(wr * 64 + fr, fq * 8), boff = lds_byte(wc * 32 + fr, fq * 8);
#define PG8_SA(b, h) (((b) * 2 + (h)) * HTB)
#define PG8_SB(b, h) ((4 + (b) * 2 + (h)) * HTB)
#define PG8_STAGE(bufoff, gbase, voff) do { _Pragma("unroll") for (int _i = 0; _i < 2; ++_i) \
        __builtin_amdgcn_global_load_lds((const unsigned*)((const char*)(gbase) + (voff)[_i]), (PG8_LAS unsigned*)(lds + (bufoff) + ldsw + _i * 8192), 16, 0, 0); } while (0)
#define PG8_LDA(dst, b, h) do { _Pragma("unroll") for (int m = 0; m < 4; ++m) _Pragma("unroll") for (int k = 0; k < 2; ++k) dst[m][k] = *(const PG8_LAS bf16x8*)(lds + PG8_SA(b, h) + aoff + m * 2048 + k * 1024); } while (0)
#define PG8_LDB(dst, b, h) do { _Pragma("unroll") for (int n = 0; n < 2; ++n) _Pragma("unroll") for (int k = 0; k < 2; ++k) dst[n][k] = *(const PG8_LAS bf16x8*)(lds + PG8_SB(b, h) + boff + n * 2048 + k * 1024); } while (0)
#define PG8_MMA(ai, bj, At, Bt) do { __builtin_amdgcn_s_setprio(1); _Pragma("unroll") for (int m = 0; m < 4; ++m) _Pragma("unroll") for (int n = 0; n < 2; ++n) _Pragma("unroll") for (int k = 0; k < 2; ++k) \
        acc[ai][bj][m][n] = __builtin_amdgcn_mfma_f32_16x16x32_bf16(Bt[n][k], At[m][k], acc[ai][bj][m][n], 0, 0, 0); __builtin_amdgcn_s_setprio(0); } while (0)
#define PG8_WAIT_V(n) asm volatile("s_waitcnt vmcnt(" #n ")" ::: "memory")
#define PG8_WAIT_L(n) asm volatile("s_waitcnt lgkmcnt(" #n ")" ::: "memory")
#define PG8_BAR __builtin_amdgcn_s_barrier()
#define PG8_SCHED __builtin_amdgcn_sched_barrier(0)
    Unit cur, nxt; int ui = 0;
    if (!S.next(0, cur)) return;
    f32x4 acc[2][2][4][2];
#pragma unroll
    for (int a = 0; a < 2; ++a)
#pragma unroll
        for (int b = 0; b < 2; ++b)
#pragma unroll
            for (int m = 0; m < 4; ++m)
#pragma unroll
                for (int n = 0; n < 2; ++n) acc[a][b][m][n] = (f32x4){0.f, 0.f, 0.f, 0.f};
    bf16x8 At[4][2], B0[2][2], B1[2][2];
    const char* cA = (const char*)g.A + (size_t)cur.pm * tstep; const char* cB = (const char*)g.Bt + (size_t)cur.pn * tstep;
    S.a_ready(cur);
    if constexpr (SP2) {
        PG8_STAGE(PG8_SB(0, 0), cB, voffB); PG8_STAGE(PG8_SB(0, 1), cB + hstep, voffB); PG8_STAGE(PG8_SA(0, 0), cA, voffA); PG8_STAGE(PG8_SA(0, 1), cA + hstep, voffA);
        if (wr == 1) PG8_BAR;
        PG8_WAIT_V(2); PG8_BAR;
        PG8_STAGE(PG8_SB(1, 0), cB + kstep, voffB); PG8_STAGE(PG8_SA(1, 0), cA + kstep, voffA); PG8_STAGE(PG8_SB(1, 1), cB + hstep + kstep, voffB);
        PG8_WAIT_V(6); PG8_BAR;
    } else {
        PG8_STAGE(PG8_SB(0, 0), cB, voffB); PG8_STAGE(PG8_SA(0, 0), cA, voffA); PG8_STAGE(PG8_SB(0, 1), cB + hstep, voffB); PG8_STAGE(PG8_SA(0, 1), cA + hstep, voffA);
        if (wr == 1) PG8_BAR;
        PG8_WAIT_V(4); PG8_BAR;
        PG8_STAGE(PG8_SB(1, 0), cB + kstep, voffB); PG8_STAGE(PG8_SA(1, 0), cA + kstep, voffA); PG8_STAGE(PG8_SB(1, 1), cB + hstep + kstep, voffB);
        PG8_WAIT_V(6); PG8_BAR;
    }
    for (;;) {
        const bool has_next = S.next(ui + 1, nxt);
        const char* nA = has_next ? (const char*)g.A + (size_t)nxt.pm * tstep : cA; const char* nB = has_next ? (const char*)g.Bt + (size_t)nxt.pn * tstep : cB;
        for (int t = 0; t < nt; t += 2) {
            const bool last = (t == nt - 2);
            const char* a1 = cA + (size_t)(t + 1) * kstep;
            const char* a2 = last ? nA : cA + (size_t)(t + 2) * kstep; const char* b2 = last ? nB : cB + (size_t)(t + 2) * kstep;
            const char* a3 = a2 + kstep; const char* b3 = b2 + kstep;
            if (last && has_next) S.a_ready(nxt);
            if constexpr (SP2) {
            PG8_LDB(B0, 0, 0); PG8_LDB(B1, 0, 1); PG8_SCHED; PG8_LDA(At, 0, 0); PG8_STAGE(PG8_SA(1, 1), a1 + hstep, voffA);
            PG8_WAIT_V(8); PG8_WAIT_L(0); PG8_BAR; PG8_MMA(0, 0, At, B0); PG8_MMA(0, 1, At, B1); PG8_BAR; PG8_SCHED;
            PG8_LDA(At, 0, 1); PG8_STAGE(PG8_SB(0, 0), b2, voffB); PG8_STAGE(PG8_SB(0, 1), b2 + hstep, voffB); PG8_STAGE(PG8_SA(0, 0), a2, voffA);
            PG8_WAIT_V(8); PG8_WAIT_L(0); PG8_BAR; PG8_MMA(1, 0, At, B0); PG8_MMA(1, 1, At, B1); PG8_BAR; PG8_SCHED;
            PG8_LDB(B0, 1, 0); PG8_LDB(B1, 1, 1); PG8_SCHED; PG8_LDA(At, 1, 0); PG8_STAGE(PG8_SA(0, 1), a2 + hstep, voffA);
            PG8_WAIT_V(8); PG8_WAIT_L(0); PG8_BAR; PG8_MMA(0, 0, At, B0); PG8_MMA(0, 1, At, B1); PG8_BAR; PG8_SCHED;
            PG8_LDA(At, 1, 1); PG8_STAGE(PG8_SB(1, 0), b3, voffB); PG8_STAGE(PG8_SB(1, 1), b3 + hstep, voffB); PG8_STAGE(PG8_SA(1, 0), a3, voffA);
            PG8_WAIT_V(8); PG8_WAIT_L(0); PG8_BAR; PG8_MMA(1, 0, At, B0); PG8_MMA(1, 1, At, B1); PG8_BAR; PG8_SCHED;
            } else {
            PG8_LDB(B0, 0, 0); PG8_SCHED; PG8_LDA(At, 0, 0); PG8_STAGE(PG8_SA(1, 1), a1 + hstep, voffA);
            PG8_WAIT_L(8); PG8_BAR; PG8_WAIT_L(0); PG8_MMA(0, 0, At, B0); PG8_BAR; PG8_SCHED;
            PG8_LDB(B1, 0, 1); PG8_STAGE(PG8_SB(0, 0), b2, voffB);
            PG8_BAR; PG8_WAIT_L(0); PG8_MMA(0, 1, At, B1); PG8_BAR;
            PG8_LDA(At, 0, 1); PG8_STAGE(PG8_SA(0, 0), a2, voffA);
            PG8_BAR; PG8_WAIT_L(0); PG8_MMA(1, 0, At, B0); PG8_BAR; PG8_SCHED;
            PG8_STAGE(PG8_SB(0, 1), b2 + hstep, voffB);
            PG8_WAIT_V(6); PG8_BAR; PG8_MMA(1, 1, At, B1); PG8_BAR;
            PG8_LDB(B0, 1, 0); PG8_SCHED; PG8_LDA(At, 1, 0); PG8_STAGE(PG8_SA(0, 1), a2 + hstep, voffA);
            PG8_WAIT_L(8); PG8_BAR; PG8_WAIT_L(0); PG8_MMA(0, 0, At, B0); PG8_BAR; PG8_SCHED;
            PG8_LDB(B1, 1, 1); PG8_STAGE(PG8_SB(1, 0), b3, voffB);
            PG8_BAR; PG8_WAIT_L(0); PG8_MMA(0, 1, At, B1); PG8_BAR;
            PG8_LDA(At, 1, 1); PG8_STAGE(PG8_SA(1, 0), a3, voffA);
            PG8_BAR; PG8_WAIT_L(0); PG8_MMA(1, 0, At, B0); PG8_BAR; PG8_SCHED;
            PG8_STAGE(PG8_SB(1, 1), b3 + hstep, voffB);
            PG8_WAIT_V(6); PG8_BAR; PG8_MMA(1, 1, At, B1); PG8_BAR;
            }
        }
        if constexpr (ALIGN_EPI) { if (wr == 0) PG8_BAR; }
        if constexpr (!Epi::AFTER_DRAIN) { E(acc, cur, wr, wc, fr, fq); S.done(cur); }
        if (!has_next) break;
#pragma unroll
        for (int a = 0; a < 2; ++a)
#pragma unroll
            for (int b = 0; b < 2; ++b)
#pragma unroll
                for (int m = 0; m < 4; ++m)
#pragma unroll
                    for (int n = 0; n < 2; ++n) acc[a][b][m][n] = (f32x4){0.f, 0.f, 0.f, 0.f};
        cur = nxt; cA = nA; cB = nB; ++ui;
        if constexpr (ALIGN_EPI) { if (wr == 1) PG8_BAR; }
    }
    PG8_WAIT_V(0);
    if constexpr (!ALIGN_EPI) { if (wr == 0) PG8_BAR; }
    PG8_BAR;
    if constexpr (Epi::AFTER_DRAIN) { E.fused(acc, cur, wr, wc, fr, fq, lds, wid, lane); S.done(cur); }
#undef PG8_SA
#undef PG8_SB
#undef PG8_STAGE
#undef PG8_LDA
#undef PG8_LDB
#undef PG8_MMA
#undef PG8_WAIT_V
#undef PG8_WAIT_L
#undef PG8_BAR
#undef PG8_SCHED
}
}

#include <hip/hip_cooperative_groups.h>
namespace cg = cooperative_groups;
#define LAS __attribute__((address_space(3)))
typedef unsigned short bf16;
typedef float f32x4 __attribute__((ext_vector_type(4)));
typedef float f32x16 __attribute__((ext_vector_type(16)));
typedef short bf16x8 __attribute__((ext_vector_type(8)));
typedef unsigned u32x4 __attribute__((ext_vector_type(4)));
typedef unsigned u32x2 __attribute__((ext_vector_type(2)));

constexpr int NWAVES = 8, NTHREADS = 512;
constexpr int DM = 1024, BATCH = 8, SEQ = 2048, MTOK = BATCH * SEQ;
constexpr int NH = 8, DFF = 2816, GHALF = 2048;
constexpr float LN_EPS = 1e-5f;
constexpr float ALPHA = 1.41421356237309515f;
constexpr float LOG2E = 1.4426950408889634f;
constexpr float QSCALE = 0.125f * LOG2E;
constexpr float LAMBDA_INIT = 0.2f;

constexpr size_t MiB = 1u << 20;
constexpr size_t WS_STATS = 0;
constexpr size_t WS_R2 = 512 * 1024;
constexpr size_t WS_WSB = 1 * MiB;
constexpr size_t WS_QKT = 2 * MiB, WS_VT_W = 6 * MiB, WS_WOT = 8 * MiB, WS_GUT = 10 * MiB  , WS_DT = 32 * MiB  ;
constexpr size_t WS_WINT = 43 * MiB, WS_WOUTT = 51 * MiB, WS_XB = 55 * MiB, WS_REG = 87 * MiB, WS_END = 215 * MiB;
constexpr size_t GUT_BYTES = 11 * MiB, DT_BYTES = (size_t)1024 * 2816 * 2;
constexpr size_t R_QK = 0, R_VT = 64 * MiB, R_AO = 96 * MiB;
constexpr size_t R_H = 0;
constexpr size_t R_ZU = 0, R_VT2 = 64 * MiB;

constexpr int LDS_BYTES = 147456;

__device__ __forceinline__ unsigned cvtpk(float lo, float hi) { return pg8::cvt_pk_bf16(lo, hi); }
__device__ __forceinline__ float bf2f(unsigned short b) { return __uint_as_float(((unsigned)b) << 16); }
__device__ __forceinline__ float wave_sum(float v) {
#pragma unroll
    for (int o = 1; o < 64; o <<= 1) v += __shfl_xor(v, o);
    return v;
}
#define WG_BAR() do { asm volatile("s_waitcnt vmcnt(0) lgkmcnt(0)" ::: "memory"); __builtin_amdgcn_s_barrier(); asm volatile("" ::: "memory"); } while (0)

__device__ __forceinline__ void tr_item(const float* W, int ldw, bf16* WT, int ldt, int k0, int n0, int drow0, LAS float* scr, int lane) {
#pragma unroll 8
    for (int i = 0; i < 32; ++i) { const int kk = 2 * i + (lane >> 5); scr[kk * 33 + (lane & 31)] = W[(size_t)(k0 + kk) * ldw + n0 + (lane & 31)]; }
    asm volatile("s_waitcnt lgkmcnt(0)" ::: "memory");
    const int c = lane & 7;
#pragma unroll
    for (int j = 0; j < 4; ++j) { const int n = (lane >> 3) + 8 * j; const LAS float* s = scr + (8 * c) * 33 + n;
        u32x4 o; o.x = cvtpk(s[0 * 33], s[1 * 33]); o.y = cvtpk(s[2 * 33], s[3 * 33]); o.z = cvtpk(s[4 * 33], s[5 * 33]); o.w = cvtpk(s[6 * 33], s[7 * 33]);
        *(u32x4*)(WT + (size_t)(drow0 + n) * ldt + k0 + 8 * c) = o; }
    asm volatile("s_waitcnt lgkmcnt(0)" ::: "memory");
}

struct Args {
    const float* in[22]; float* out; unsigned char* ws; int ph_lo, ph_hi;
};
#define CAS __attribute__((address_space(4)))
typedef const CAS Args* ArgsP;
__device__ __forceinline__ ArgsP kargs() { ArgsP p = (ArgsP)__builtin_amdgcn_kernarg_segment_ptr(); asm volatile("" : "+s"(p)); return p; }
enum { I_X = 0, I_WQKV, I_LQ1, I_LK1, I_LQ2, I_LK2, I_SUBG, I_WO, I_GWIN, I_GBIN, I_GLNG, I_GLNB, I_GWS, I_GBS, I_GWOUT, I_LNMG, I_LNMB, I_FG, I_FU, I_FD, I_LNFG, I_LNFB };

__device__ __forceinline__ void prologue(const CAS Args& a, LAS unsigned char* lds, int vcu, int G) {
    int tid_ = threadIdx.x; asm volatile("" : "+v"(tid_));
    const int tid = tid_, lane = tid & 63, wave = __builtin_amdgcn_readfirstlane(tid >> 6);
    unsigned char* ws = a.ws;
    LAS float* scr = (LAS float*)(lds + wave * 16384);
    const int gw = vcu * NWAVES + wave, NGW = G * NWAVES;
    constexpr int IT_QK = 16 * 64, IT_V = 16 * 32, IT_WO = 16 * 32, IT_G = 16 * 88, IT_D = 44 * 32, IT_WIN = 16 * 128, IT_WOUT = 32 * 32;
    constexpr int NITEMS = IT_QK + IT_V + IT_WO + 2 * (2 * IT_G + IT_D) + IT_WIN + IT_WOUT;
    for (int it = gw; it < NITEMS; it += NGW) {
        int r = it;
        if (r < IT_QK) { const int kb = r / 64, nb = r % 64; tr_item(a.in[I_WQKV], 3072, (bf16*)(ws + WS_QKT), 1024, 64 * kb, 32 * nb, 32 * nb, scr, lane); continue; } r -= IT_QK;
        if (r < IT_V) { const int kb = r / 32, nb = r % 32; tr_item(a.in[I_WQKV] + 2048, 3072, (bf16*)(ws + WS_VT_W), 1024, 64 * kb, 32 * nb, 32 * nb, scr, lane); continue; } r -= IT_V;
        if (r < IT_WO) { const int kb = r / 32, nb = r % 32; tr_item(a.in[I_WO], 1024, (bf16*)(ws + WS_WOT), 1024, 64 * kb, 32 * nb, 32 * nb, scr, lane); continue; } r -= IT_WO;
        { constexpr int PER = 2 * IT_G + IT_D;
          if (r < 2 * PER) { const int L = r / PER; const int rr = r % PER;
              if (rr < IT_G) { const int kb = rr / 88, nb = rr % 88, n0 = 32 * nb; tr_item(a.in[I_FG] + (size_t)L * 1024 * 2816, 2816, (bf16*)(ws + WS_GUT + L * GUT_BYTES), 1024, 64 * kb, n0, (n0 >> 7) * 256 + (n0 & 127), scr, lane); }
              else if (rr < 2 * IT_G) { const int r2_ = rr - IT_G; const int kb = r2_ / 88, nb = r2_ % 88, n0 = 32 * nb; tr_item(a.in[I_FU] + (size_t)L * 1024 * 2816, 2816, (bf16*)(ws + WS_GUT + L * GUT_BYTES), 1024, 64 * kb, n0, (n0 >> 7) * 256 + 128 + (n0 & 127), scr, lane); }
              else { const int r3_ = rr - 2 * IT_G; const int kb = r3_ / 32, nb = r3_ % 32; tr_item(a.in[I_FD] + (size_t)L * 2816 * 1024, 1024, (bf16*)(ws + WS_DT + L * DT_BYTES), 2816, 64 * kb, 32 * nb, 32 * nb, scr, lane); }
              continue; }
          r -= 2 * PER; }
        if (r < IT_WIN) { const int kb = r / 128, nb = r % 128; tr_item(a.in[I_GWIN], 4096, (bf16*)(ws + WS_WINT), 1024, 64 * kb, 32 * nb, 32 * nb, scr, lane); continue; } r -= IT_WIN;
        { const int kb = r / 32, nb = r % 32; tr_item(a.in[I_GWOUT], 1024, (bf16*)(ws + WS_WOUTT), 2048, 64 * kb, 32 * nb, 32 * nb, scr, lane); }
    }
    { const float* x = a.in[I_X]; bf16* xb = (bf16*)(ws + WS_XB); const size_t n8 = (size_t)MTOK * DM / 8;
      for (size_t i = (size_t)vcu * NTHREADS + tid; i < n8; i += (size_t)G * NTHREADS) { const f32x4 v0 = *(const f32x4*)(x + 8 * i), v1 = *(const f32x4*)(x + 8 * i + 4); *(u32x4*)(xb + 8 * i) = pg8::pack8(v0, v1); } }
    { const float* wsrc = a.in[I_GWS]; bf16* wsb = (bf16*)(ws + WS_WSB); float* r2 = (float*)(ws + WS_R2);
      for (int row = gw; row < 8 * 128; row += NGW) { const int t = row & 127; float s = 0.f;
#pragma unroll
          for (int j = 0; j < 2; ++j) { const int sidx = lane + 64 * j; float w = wsrc[(size_t)row * 128 + sidx]; if (sidx > t) w = 0.f; const unsigned b = cvtpk(w, 0.f) & 0xffffu; wsb[(size_t)row * 128 + sidx] = (bf16)b; s += bf2f((unsigned short)b); }
          s = wave_sum(s); if (lane == 0) r2[row] = s; }
      float* st = (float*)(ws + WS_STATS);
      for (int i = vcu * NTHREADS + tid; i < MTOK * 2; i += G * NTHREADS) st[i] = 0.f; }
}

__device__ __forceinline__ void ln_rows(const float* src, const float* gamma, const float* beta, float* outf, bf16* outb, int vcu, int G) {
    int tid_ = threadIdx.x; asm volatile("" : "+v"(tid_));
    const int tid = tid_, lane = tid & 63, wave = __builtin_amdgcn_readfirstlane(tid >> 6);
    const int gw = vcu * NWAVES + wave, NGW = G * NWAVES;
    f32x4 gm[4], bt[4];
#pragma unroll
    for (int j = 0; j < 4; ++j) { gm[j] = *(const f32x4*)(gamma + 4 * lane + 256 * j); bt[j] = *(const f32x4*)(beta + 4 * lane + 256 * j); }
    for (int m = gw; m < MTOK; m += NGW) {
        const f32x4* xr = (const f32x4*)(src + (size_t)m * DM) + lane;
        f32x4 v[4]; float s = 0.f;
#pragma unroll
        for (int j = 0; j < 4; ++j) { v[j] = xr[64 * j]; s += (v[j].x + v[j].y) + (v[j].z + v[j].w); }
        const float mean = wave_sum(s) * (1.f / DM); float s2 = 0.f;
#pragma unroll
        for (int j = 0; j < 4; ++j) { v[j] = v[j] - mean; s2 += (v[j].x * v[j].x + v[j].y * v[j].y) + (v[j].z * v[j].z + v[j].w * v[j].w); }
        const float rstd = 1.f / sqrtf(wave_sum(s2) * (1.f / DM) + LN_EPS);
#pragma unroll
        for (int j = 0; j < 4; ++j) { v[j] = v[j] * rstd * gm[j] + bt[j]; }
        f32x4* of = (f32x4*)(outf + (size_t)m * DM) + lane;
#pragma unroll
        for (int j = 0; j < 4; ++j) of[64 * j] = v[j];
        if (outb) { u32x2* ob = (u32x2*)(outb + (size_t)m * DM) + lane;
#pragma unroll
            for (int j = 0; j < 4; ++j) { u32x2 w; w.x = cvtpk(v[j].x, v[j].y); w.y = cvtpk(v[j].z, v[j].w); ob[64 * j] = w; } }
    }
}

namespace att {
constexpr int KROW = 272, VROW = 144, KBUF = 64 * KROW, VBUF = 128 * VROW, STG = KBUF + VBUF;
__device__ __forceinline__ int pi5(int k) { return (k & ~12) | ((k & 4) << 1) | ((k & 8) >> 1); }

__device__ __forceinline__ void unit(LAS unsigned char* lds, const bf16* QK, const bf16* VT, bf16* AO, const float* gsub, int b, int h, int qb, float lam) {
    int tid_ = threadIdx.x; asm volatile("" : "+v"(tid_));
    const int tid = tid_, lane = tid & 63, r32 = lane & 31, hi = lane >> 5, wid = __builtin_amdgcn_readfirstlane(tid >> 6);
    const int rg = wid & 3, c = wid >> 2;
    const int q0 = qb * 128 + rg * 32, mychunk = q0 >> 6, NT = 2 * qb + 2;
    const size_t tokbase = (size_t)b * SEQ;
    const float slope2 = LOG2E * __builtin_amdgcn_exp2f(-(float)(h + 1));
    bf16x8 qf[4];
    { const bf16* qp = QK + (tokbase + q0 + r32) * 2048 + h * 128 + c * 64 + hi * 8;
#pragma unroll
      for (int d0 = 0; d0 < 4; ++d0) qf[d0] = *(const bf16x8*)(qp + d0 * 16); }
    const bf16* ksrc[2]; const bf16* vsrc[2]; int kdst[2], vdst[2];
#pragma unroll
    for (int i = 0; i < 2; ++i) { const int idx = tid + NTHREADS * i; const int key = idx >> 4, ch = idx & 15;
        ksrc[i] = QK + (tokbase + key) * 2048 + 1024 + h * 128 + ch * 8; kdst[i] = pi5(key) * KROW + ch * 16;
        const int d = idx >> 3, cv = idx & 7;
        vsrc[i] = VT + (size_t)(h * 128 + d) * MTOK + tokbase + cv * 8; vdst[i] = KBUF + d * VROW + cv * 16; }
    u32x4 kreg[2], vreg[2];
#define ATT_LOAD(t) do { _Pragma("unroll") for (int i = 0; i < 2; ++i) { kreg[i] = *(const u32x4*)(ksrc[i] + (size_t)(t) * 64 * 2048); vreg[i] = *(const u32x4*)(vsrc[i] + (t) * 64); } } while (0)
#define ATT_STORE(s) do { _Pragma("unroll") for (int i = 0; i < 2; ++i) { *(LAS u32x4*)(lds + (s) * STG + kdst[i]) = kreg[i]; *(LAS u32x4*)(lds + (s) * STG + vdst[i]) = vreg[i]; } } while (0)
    ATT_LOAD(0); ATT_STORE(0); WG_BAR();
    f32x16 o[4];
#pragma unroll
    for (int d = 0; d < 4; ++d)
#pragma unroll
        for (int r = 0; r < 16; ++r) o[d][r] = 0.f;
    float m_run = -1e30f, l_run = 0.f;
    const float qposf = (float)(q0 + r32);
    for (int t = 0; t < NT; ++t) {
        if (t + 1 < NT) ATT_LOAD(t + 1);
        if (t <= mychunk) {
            const LAS unsigned char* Kb = lds + (t & 1) * STG + c * 128 + r32 * KROW + hi * 16;
            const LAS unsigned char* Vb = lds + (t & 1) * STG + KBUF + r32 * VROW + hi * 16;
            f32x16 p0, p1;
#pragma unroll
            for (int r = 0; r < 16; ++r) { p0[r] = 0.f; p1[r] = 0.f; }
#pragma unroll
            for (int d0 = 0; d0 < 4; ++d0) {
                const bf16x8 a0 = *(const LAS bf16x8*)(Kb + d0 * 32), a1 = *(const LAS bf16x8*)(Kb + 32 * KROW + d0 * 32);
                p0 = __builtin_amdgcn_mfma_f32_32x32x16_bf16(a0, qf[d0], p0, 0, 0, 0);
                p1 = __builtin_amdgcn_mfma_f32_32x32x16_bf16(a1, qf[d0], p1, 0, 0, 0);
            }
            const float dq = qposf - (float)(64 * t + 8 * hi);
            float mx = -1e30f;
#pragma unroll
            for (int r = 0; r < 16; ++r) { const float kk = (float)(16 * (r >> 3) + (r & 7));
                p0[r] = __builtin_fmaf(-slope2, __builtin_fabsf(dq - kk), p0[r]); p1[r] = __builtin_fmaf(-slope2, __builtin_fabsf(dq - kk - 32.f), p1[r]);
                mx = __builtin_fmaxf(mx, __builtin_fmaxf(p0[r], p1[r])); }
            mx = __builtin_fmaxf(mx, __shfl_xor(mx, 32));
            const float mnew = __builtin_fmaxf(m_run, mx), f = __builtin_amdgcn_exp2f(m_run - mnew);
            m_run = mnew; l_run *= f;
#pragma unroll
            for (int d = 0; d < 4; ++d)
#pragma unroll
                for (int r = 0; r < 16; ++r) o[d][r] *= f;
            float ps = 0.f;
#pragma unroll
            for (int r = 0; r < 16; ++r) { p0[r] = __builtin_amdgcn_exp2f(p0[r] - mnew); p1[r] = __builtin_amdgcn_exp2f(p1[r] - mnew); ps += p0[r] + p1[r]; }
            l_run += ps;
            u32x4 pk[4];
#pragma unroll
            for (int j = 0; j < 4; ++j) { pk[0][j] = cvtpk(p0[2 * j], p0[2 * j + 1]); pk[1][j] = cvtpk(p0[8 + 2 * j], p0[9 + 2 * j]); pk[2][j] = cvtpk(p1[2 * j], p1[2 * j + 1]); pk[3][j] = cvtpk(p1[8 + 2 * j], p1[9 + 2 * j]); }
#pragma unroll
            for (int d = 0; d < 4; ++d)
#pragma unroll
                for (int ks = 0; ks < 4; ++ks) {
                    const bf16x8 vf = *(const LAS bf16x8*)(Vb + d * 32 * VROW + ks * 32);
                    o[d] = __builtin_amdgcn_mfma_f32_32x32x16_bf16(vf, __builtin_bit_cast(bf16x8, pk[ks]), o[d], 0, 0, 0);
                }
        }
        if (t + 1 < NT) ATT_STORE((t + 1) & 1);
        WG_BAR();
    }
#undef ATT_LOAD
#undef ATT_STORE
    const float linv = 1.f / (l_run + __shfl_xor(l_run, 32));
    LAS float* comb = (LAS float*)lds + rg * 4096 + lane;
    if (c == 1) {
#pragma unroll
        for (int d = 0; d < 4; ++d)
#pragma unroll
            for (int r = 0; r < 16; ++r) comb[(d * 16 + r) * 64] = o[d][r] * linv;
    }
    WG_BAR();
    if (c == 0) {
        float ss = 0.f;
#pragma unroll
        for (int d = 0; d < 4; ++d)
#pragma unroll
            for (int r = 0; r < 16; ++r) { const float v = o[d][r] * linv - lam * comb[(d * 16 + r) * 64]; o[d][r] = v; ss += v * v; }
        ss += __shfl_xor(ss, 32);
        const float rs = (1.f - LAMBDA_INIT) / sqrtf(ss * (1.f / 128.f) + LN_EPS);
        bf16* op = AO + (tokbase + q0 + r32) * 1024 + h * 128 + 4 * hi;
#pragma unroll
        for (int d = 0; d < 4; ++d)
#pragma unroll
            for (int g4 = 0; g4 < 4; ++g4) { const int dd = 32 * d + 8 * g4; const f32x4 gs = *(const f32x4*)(gsub + dd + 4 * hi);
                u32x2 w; w.x = cvtpk(o[d][4 * g4] * rs * gs[0], o[d][4 * g4 + 1] * rs * gs[1]); w.y = cvtpk(o[d][4 * g4 + 2] * rs * gs[2], o[d][4 * g4 + 3] * rs * gs[3]);
                *(u32x2*)(op + dd) = w; }
    }
    WG_BAR();
}

__device__ __forceinline__ void phase(LAS unsigned char* lds, const CAS Args& a, int vcu, int G) {
    const bf16* QK = (const bf16*)(a.ws + WS_REG + R_QK); const bf16* VT = (const bf16*)(a.ws + WS_REG + R_VT); bf16* AO = (bf16*)(a.ws + WS_REG + R_AO);
    float d1 = 0.f, d2 = 0.f;
    for (int i = 0; i < 64; ++i) { d1 += a.in[I_LQ1][i] * a.in[I_LK1][i]; d2 += a.in[I_LQ2][i] * a.in[I_LK2][i]; }
    const float lam = __expf(d1) - __expf(d2) + LAMBDA_INIT;
    for (int w = vcu; w < 256; w += G) {
        const int bh = w >> 2, j = w & 3, b = bh >> 3, h = bh & 7;
#pragma unroll 1
        for (int i = 0; i < 4; ++i) { const int qb = (i == 0) ? j : (i == 1) ? 15 - j : (i == 2) ? j + 4 : 11 - j; unit(lds, QK, VT, AO, a.in[I_SUBG], b, h, qb, lam); }
    }
}
}

namespace gat {
constexpr int ROWB = 272;
constexpr int L_VT = 0, L_W = 256 * ROWB, L_MEAN = L_W + 128 * ROWB, L_RSTD = L_MEAN + 512, L_R1 = L_RSTD + 512, L_END = L_R1 + 512;
static_assert(L_END <= 131072, "gating LDS");
__device__ __forceinline__ void unit(LAS unsigned char* lds, const CAS Args& a, int n, int g) {
    int tid_ = threadIdx.x; asm volatile("" : "+v"(tid_));
    const int tid = tid_, lane = tid & 63, r32 = lane & 31, hi = lane >> 5, wid = __builtin_amdgcn_readfirstlane(tid >> 6);
    unsigned char* ws = a.ws;
    const bf16* VT2 = (const bf16*)(ws + WS_REG + R_VT2); bf16* ZU = (bf16*)(ws + WS_REG + R_ZU);
    const float* stats = (const float*)(ws + WS_STATS); const bf16* wsb = (const bf16*)(ws + WS_WSB) + (size_t)g * 128 * 128; const float* r2 = (const float*)(ws + WS_R2) + g * 128;
    LAS float* Lmean = (LAS float*)(lds + L_MEAN); LAS float* Lrstd = (LAS float*)(lds + L_RSTD); LAS float* Lr1 = (LAS float*)(lds + L_R1);
    if (tid < 128) { const float s = stats[2 * (n * 128 + tid)], q = stats[2 * (n * 128 + tid) + 1]; const float mean = s * (1.f / GHALF); const float var = __builtin_fmaxf(q * (1.f / GHALF) - mean * mean, 0.f);
        Lmean[tid] = mean; Lrstd[tid] = 1.f / sqrtf(var + LN_EPS); }
#pragma unroll
    for (int i = 0; i < 8; ++i) { const int idx = tid + NTHREADS * i, c = idx >> 4, ch = idx & 15;
        const u32x4 v = *(const u32x4*)(VT2 + (size_t)(g * 256 + c) * MTOK + n * 128 + ch * 8); *(LAS u32x4*)(lds + L_VT + c * ROWB + ch * 16) = v; }
    WG_BAR();
#pragma unroll
    for (int i = 0; i < 4; ++i) { const int idx = tid + NTHREADS * i, t = idx >> 4, ch = idx & 15;
        const u32x4 v = *(const u32x4*)(wsb + t * 128 + ch * 8); u32x4 w;
#pragma unroll
        for (int e = 0; e < 4; ++e) { const float lo = __uint_as_float(v[e] << 16) * Lrstd[ch * 8 + 2 * e], hh = __uint_as_float(v[e] & 0xffff0000u) * Lrstd[ch * 8 + 2 * e + 1]; w[e] = cvtpk(lo, hh); }
        *(LAS u32x4*)(lds + L_W + t * ROWB + ch * 16) = w; }
    WG_BAR();
    if (tid < 128) { const LAS unsigned short* wr_ = (const LAS unsigned short*)(lds + L_W + tid * ROWB); float s = 0.f;
        for (int k = 0; k < 128; ++k) s += bf2f(wr_[k]) * Lmean[k];
        Lr1[tid] = s; }
    f32x16 acc[4];
#pragma unroll
    for (int tb = 0; tb < 4; ++tb)
#pragma unroll
        for (int r = 0; r < 16; ++r) acc[tb][r] = 0.f;
    { const LAS unsigned char* Ab = lds + L_VT + (32 * wid + r32) * ROWB + hi * 16; const LAS unsigned char* Bb = lds + L_W + r32 * ROWB + hi * 16;
#pragma unroll
      for (int ks = 0; ks < 8; ++ks) { const bf16x8 af = *(const LAS bf16x8*)(Ab + ks * 32);
#pragma unroll
          for (int tb = 0; tb < 4; ++tb) if (2 * tb + 1 >= ks) { const bf16x8 bfr = *(const LAS bf16x8*)(Bb + tb * 32 * ROWB + ks * 32); acc[tb] = __builtin_amdgcn_mfma_f32_32x32x16_bf16(af, bfr, acc[tb], 0, 0, 0); } } }
    WG_BAR();
    const float* lng = a.in[I_GLNG] + g * 256 + 32 * wid + 4 * hi; const float* lnb = a.in[I_GLNB] + g * 256 + 32 * wid + 4 * hi;
    f32x4 gm[4], bt[4];
#pragma unroll
    for (int g4 = 0; g4 < 4; ++g4) { gm[g4] = *(const f32x4*)(lng + 8 * g4); bt[g4] = *(const f32x4*)(lnb + 8 * g4); }
#pragma unroll
    for (int tb = 0; tb < 4; ++tb) { const int t = 32 * tb + r32; const float r1 = Lr1[t], r2t = r2[t], bs = a.in[I_GBS][g * 128 + t];
        bf16* up = ZU + (size_t)(n * 128 + t) * GHALF + g * 256 + 32 * wid + 4 * hi;
#pragma unroll
        for (int g4 = 0; g4 < 4; ++g4) { const u32x2 uv = *(const u32x2*)(up + 8 * g4); float o4[4];
#pragma unroll
            for (int e = 0; e < 4; ++e) o4[e] = gm[g4][e] * (acc[tb][4 * g4 + e] - r1) + bt[g4][e] * r2t + bs;
            u32x2 w; w.x = cvtpk(__uint_as_float(uv.x << 16) * o4[0], __uint_as_float(uv.x & 0xffff0000u) * o4[1]); w.y = cvtpk(__uint_as_float(uv.y << 16) * o4[2], __uint_as_float(uv.y & 0xffff0000u) * o4[3]);
            *(u32x2*)(up + 8 * g4) = w; } }
    WG_BAR();
}
__device__ __forceinline__ void phase(LAS unsigned char* lds, const CAS Args& a, int vcu, int G) {
    for (int w = vcu; w < 1024; w += G) unit(lds, a, w >> 3, w & 7);
}
}

__global__ void __launch_bounds__(NTHREADS, 2) fwd_kernel(Args args_unused) {
    extern __shared__ __attribute__((aligned(16))) unsigned char lds_raw[];
    LAS unsigned char* lds = (LAS unsigned char*)lds_raw;
    cg::grid_group grid = cg::this_grid();
    const int G = gridDim.x, bx = blockIdx.x;
    const int vcu = (G % 8 == 0) ? (bx % 8) * (G / 8) + bx / 8 : bx;
    int lo, hi; { ArgsP kp = kargs(); lo = kp->ph_lo; hi = kp->ph_hi; }
    int ph = 0;
#define PHASE_BEGIN if (ph >= lo && ph < hi) { const CAS Args& A = *kargs(); unsigned char* ws = A.ws; bf16* XB = (bf16*)(ws + WS_XB); float* X = A.out; (void)XB; (void)X;
#define PHASE_END   if (ph + 1 < hi) grid.sync(); } ++ph;

    PHASE_BEGIN prologue(A, lds, vcu, G); PHASE_END

    PHASE_BEGIN
    { pg8::Gemm g{XB, (const bf16*)(ws + WS_QKT), MTOK, 2048, DM}; pg8::StaticOrder S; S.init(MTOK, 2048, G, bx);
      pg8::EpiScaleBf16 E{(bf16*)(ws + WS_REG + R_QK), 2048, 4, QSCALE};
      pg8::gemm_phase<pg8::EpiScaleBf16, pg8::StaticOrder, true, true>(lds, g, S, E); }
    { pg8::Gemm g{(const bf16*)(ws + WS_VT_W), XB, DM, MTOK, DM}; pg8::StaticOrder S; S.init(DM, MTOK, G, bx);
      pg8::EpiScaleBf16 E{(bf16*)(ws + WS_REG + R_VT), MTOK, 0, 1.f};
      pg8::gemm_phase<pg8::EpiScaleBf16, pg8::StaticOrder, true, true>(lds, g, S, E); }
    PHASE_END

    PHASE_BEGIN att::phase(lds, A, vcu, G); PHASE_END

    PHASE_BEGIN
    { pg8::Gemm g{(const bf16*)(ws + WS_REG + R_AO), (const bf16*)(ws + WS_WOT), MTOK, DM, DM}; pg8::StaticOrder S; S.init(MTOK, DM, G, bx);
      pg8::EpiResF32 E{A.in[I_X], X, DM, ALPHA};
      pg8::gemm_phase<pg8::EpiResF32, pg8::StaticOrder, true, true>(lds, g, S, E); }
    PHASE_END
    PHASE_BEGIN ln_rows(X, A.in[I_LNMG], A.in[I_LNMB], X, XB, vcu, G); PHASE_END

#pragma unroll 1
    for (int L = 0; L < 2; ++L) {
        if (L == 1) {
            PHASE_BEGIN
            { pg8::Gemm g{XB, (const bf16*)(ws + WS_WINT), MTOK, GHALF, DM}; pg8::StaticOrder S; S.init(MTOK, GHALF, G, bx);
              pg8::EpiGeluColBias E{(bf16*)(ws + WS_REG + R_ZU), GHALF, A.in[I_GBIN]};
              pg8::gemm_phase<pg8::EpiGeluColBias, pg8::StaticOrder, true, true>(lds, g, S, E); }
            PHASE_END
            PHASE_BEGIN
            { pg8::Gemm g{(const bf16*)(ws + WS_WINT) + (size_t)GHALF * DM, XB, GHALF, MTOK, DM}; pg8::StaticOrder S; S.init(GHALF, MTOK, G, bx);
              pg8::EpiGeluRowBiasStats E{(bf16*)(ws + WS_REG + R_VT2), MTOK, A.in[I_GBIN] + GHALF, (float*)(ws + WS_STATS)};
              pg8::gemm_phase<pg8::EpiGeluRowBiasStats, pg8::StaticOrder, true, true>(lds, g, S, E); }
            PHASE_END
            PHASE_BEGIN gat::phase(lds, A, vcu, G); PHASE_END
            PHASE_BEGIN
            { pg8::Gemm g{(const bf16*)(ws + WS_REG + R_ZU), (const bf16*)(ws + WS_WOUTT), MTOK, DM, GHALF}; pg8::StaticOrder S; S.init(MTOK, DM, G, bx);
              pg8::EpiResF32 E{X, X, DM, ALPHA};
              pg8::gemm_phase<pg8::EpiResF32, pg8::StaticOrder, true, true>(lds, g, S, E); }
            PHASE_END
            PHASE_BEGIN ln_rows(X, A.in[I_LNMG] + DM, A.in[I_LNMB] + DM, X, XB, vcu, G); PHASE_END
        }
        PHASE_BEGIN
        { pg8::Gemm g{XB, (const bf16*)(ws + WS_GUT + L * GUT_BYTES), MTOK, 2 * DFF, DM}; pg8::StaticOrder S; S.init(MTOK, 2 * DFF, G, bx);
          pg8::EpiSwiglu E{(bf16*)(ws + WS_REG + R_H), DFF};
          pg8::gemm_phase<pg8::EpiSwiglu, pg8::StaticOrder, true, true>(lds, g, S, E); }
        PHASE_END
        PHASE_BEGIN
        { pg8::Gemm g{(const bf16*)(ws + WS_REG + R_H), (const bf16*)(ws + WS_DT + L * DT_BYTES), MTOK, DM, DFF}; pg8::StaticOrder S; S.init(MTOK, DM, G, bx);
          pg8::EpiResF32 E{X, X, DM, ALPHA};
          pg8::gemm_phase<pg8::EpiResF32, pg8::StaticOrder, true, true>(lds, g, S, E); }
        PHASE_END
        PHASE_BEGIN ln_rows(X, A.in[I_LNFG] + L * DM, A.in[I_LNFB] + L * DM, X, (L == 0) ? XB : (bf16*)nullptr, vcu, G); PHASE_END
    }
#undef PHASE_BEGIN
#undef PHASE_END
}
constexpr int N_PHASES = 5 + 3 + 5 + 3;

#ifndef MK_PER_PHASE
#define MK_PER_PHASE 0
#endif

extern "C" void kernel_launch(void* const* d_in, const int* in_sizes, int n_in, void* d_out, int out_size, void* d_ws, size_t ws_size, hipStream_t stream) {
    static int grid = 0;
    if (grid == 0) {
        int dev = 0, cus = 0, per_cu = 0;
        hipGetDevice(&dev); hipDeviceGetAttribute(&cus, hipDeviceAttributeMultiprocessorCount, dev);
        hipFuncSetAttribute((const void*)fwd_kernel, hipFuncAttributeMaxDynamicSharedMemorySize, LDS_BYTES);
        if (hipOccupancyMaxActiveBlocksPerMultiprocessor(&per_cu, (const void*)fwd_kernel, NTHREADS, LDS_BYTES) != hipSuccess || per_cu < 1) { fprintf(stderr, "occupancy query: %d\n", per_cu); per_cu = 1; }
        (void)hipGetLastError();
        grid = cus * 1;
        if (n_in != 22 || ws_size < WS_END) { fprintf(stderr, "kernel_launch: unexpected n_in %d / ws %zu\n", n_in, ws_size); }
    }
    Args a{};
    for (int i = 0; i < 22; ++i) a.in[i] = (const float*)d_in[i];
    a.out = (float*)d_out; a.ws = (unsigned char*)d_ws;
#if MK_PER_PHASE
    for (int p = 0; p < N_PHASES; ++p) { a.ph_lo = p; a.ph_hi = p + 1; hipLaunchKernelGGL(fwd_kernel, dim3(grid), dim3(NTHREADS), LDS_BYTES, stream, a); }
#else
    a.ph_lo = 0; a.ph_hi = N_PHASES;
    void* kargs[] = {&a};
    hipError_t e = hipLaunchCooperativeKernel((const void*)fwd_kernel, dim3(grid), dim3(NTHREADS), kargs, LDS_BYTES, stream);
    if (e != hipSuccess) fprintf(stderr, "cooperative launch failed: %s (grid %d)\n", hipGetErrorString(e), grid);
#endif
}
```

```cpp
#include <hip/hip_runtime.h>
#include <cstdio>
#include <cstdint>
namespace pg8 {
#define PG8_LAS __attribute__((address_space(3)))
typedef unsigned short bf16_t;
typedef short bf16x8 __attribute__((ext_vector_type(8)));
typedef float f32x4 __attribute__((ext_vector_type(4)));
typedef unsigned u32x4 __attribute__((ext_vector_type(4)));
constexpr int BM = 256, BK = 64, HALF = 128, HTB = HALF * BK * 2  , STAGE_BYTES = 8 * HTB, NXCD = 8, WGM = 8;

__host__ __device__ __forceinline__ int lds_byte(int r, int c) { const int st = (r >> 4) * 2 + (c >> 5), rr = r & 15, cc = c & 31, ob = rr * 64 + cc * 2; return st * 1024 + (ob ^ (((ob >> 9) & 1) << 5)); }
__host__ __device__ __forceinline__ void stage_rc(int b, int& R, int& C) { const int st = b / 1024, sb = b % 1024, swz = sb ^ (((sb >> 9) & 1) << 5); R = (st >> 1) * 16 + swz / 64; C = (st & 1) * 32 + (swz % 64) / 2; }
__host__ __device__ __forceinline__ int perm32(int rho) { const int n = rho >> 4, i = rho & 15; return 8 * (i >> 2) + 4 * n + (i & 3); }

struct Unit { int pm, pn; };
struct Gemm { const bf16_t* A; const bf16_t* Bt; int M, N, K; };

struct StaticOrder {
    int nM, nN, nwg, G, c;
    __host__ __device__ void init(int M, int N, int G_, int c_) { nM = M / BM; nN = N / BM; nwg = nM * nN; G = G_; c = c_; }
    __host__ __device__ bool next(int i, Unit& u) const {
        const long L = (long)i * G + c; if (L >= nwg) return false;
        int wgid = (int)L; { const int q = nwg / NXCD, r = nwg % NXCD, xcd = wgid % NXCD, off = wgid / NXCD; wgid = (xcd < r ? xcd * (q + 1) : r * (q + 1) + (xcd - r) * q) + off; }
        const int nig = WGM * nN, gid = wgid / nig, fm = gid * WGM, gsz = (nM - fm) < WGM ? (nM - fm) : WGM;
        u.pm = fm + ((wgid % nig) % gsz); u.pn = (wgid % nig) / gsz; return true;
    }
    __device__ __forceinline__ void a_ready(const Unit&) const {}
    __device__ __forceinline__ void done(const Unit&) const {}
};

__device__ __forceinline__ unsigned cvt_pk_bf16(float lo, float hi) { unsigned r; asm volatile("v_cvt_pk_bf16_f32 %0, %1, %2" : "=v"(r) : "v"(lo), "v"(hi)); return r; }
typedef float f32x2 __attribute__((ext_vector_type(2)));
__device__ __forceinline__ f32x2 gelu_pk(f32x2 v) {
    const f32x2 av = __builtin_elementwise_abs(v), d = av * 0.2316418882f + 1.0f;
    f32x2 t; t.x = __builtin_amdgcn_rcpf(d.x); t.y = __builtin_amdgcn_rcpf(d.y);
    f32x2 q = t * 0.5307027145f + (-0.7265760135f); q = q * t + 0.7107068705f; q = q * t + (-0.142248368f); q = q * t + 0.127414796f; q = q * t;
    const f32x2 s = (v * v) * (-0.72134752044f);
    f32x2 e; e.x = __builtin_amdgcn_exp2f(s.x); e.y = __builtin_amdgcn_exp2f(s.y);
    const f32x2 m = v * (q * e), r = v - m;
    f32x2 o; o.x = v.x < 0.f ? m.x : r.x; o.y = v.y < 0.f ? m.y : r.y; return o;
}


__device__ __forceinline__ u32x4 pack8(const f32x4 v0, const f32x4 v1) { u32x4 w; w.x = cvt_pk_bf16(v0[0], v0[1]); w.y = cvt_pk_bf16(v0[2], v0[3]); w.z = cvt_pk_bf16(v1[0], v1[1]); w.w = cvt_pk_bf16(v1[2], v1[3]); return w; }
__device__ __forceinline__ f32x4 gelu4(const f32x4 v) { const f32x2 a = gelu_pk((f32x2){v[0], v[1]}), b = gelu_pk((f32x2){v[2], v[3]}); return (f32x4){a.x, a.y, b.x, b.y}; }

struct EpiScaleBf16 {
    static constexpr bool PERM = true, AFTER_DRAIN = false;
    bf16_t* O; int ldc; int npn_scaled; float scale;
    __device__ __forceinline__ void operator()(f32x4 (&acc)[2][2][4][2], const Unit& u, int wr, int wc, int fr, int fq) const {
        const int row0 = u.pm * BM + wr * 64 + fr, col0 = u.pn * BM + wc * 32 + 8 * fq;
        const float sc = (u.pn < npn_scaled) ? scale : 1.f;
#pragma unroll
        for (int ai = 0; ai < 2; ++ai)
#pragma unroll
            for (int m = 0; m < 4; ++m) { bf16_t* rowp = O + (size_t)(row0 + ai * HALF + m * 16) * ldc + col0;
#pragma unroll
                for (int bj = 0; bj < 2; ++bj) *(u32x4*)(rowp + bj * HALF) = pack8(acc[ai][bj][m][0] * sc, acc[ai][bj][m][1] * sc); }
    }
};
struct EpiGeluColBias {
    static constexpr bool PERM = true, AFTER_DRAIN = false;
    bf16_t* O; int ldc; const float* bias;
    __device__ __forceinline__ void operator()(f32x4 (&acc)[2][2][4][2], const Unit& u, int wr, int wc, int fr, int fq) const {
        const int row0 = u.pm * BM + wr * 64 + fr, col0 = u.pn * BM + wc * 32 + 8 * fq;
#pragma unroll
        for (int bj = 0; bj < 2; ++bj) { const f32x4 b0 = *(const f32x4*)(bias + col0 + bj * HALF), b1 = *(const f32x4*)(bias + col0 + bj * HALF + 4);
#pragma unroll
            for (int ai = 0; ai < 2; ++ai)
#pragma unroll
                for (int m = 0; m < 4; ++m) { bf16_t* rowp = O + (size_t)(row0 + ai * HALF + m * 16) * ldc + col0;
                    *(u32x4*)(rowp + bj * HALF) = pack8(gelu4(acc[ai][bj][m][0] + b0), gelu4(acc[ai][bj][m][1] + b1)); asm volatile("" ::: "memory"); } }
    }
};
struct EpiGeluRowBiasStats {
    static constexpr bool PERM = true, AFTER_DRAIN = false;
    bf16_t* O; int ldc; const float* bias; float* stats;
    __device__ __forceinline__ void operator()(f32x4 (&acc)[2][2][4][2], const Unit& u, int wr, int wc, int fr, int fq) const {
        const int row0 = u.pm * BM + wr * 64 + fr, col0 = u.pn * BM + wc * 32 + 8 * fq;
#pragma unroll
        for (int ai = 0; ai < 2; ++ai)
#pragma unroll
            for (int m = 0; m < 4; ++m) { const int row = row0 + ai * HALF + m * 16; const float b = bias[row]; bf16_t* rowp = O + (size_t)row * ldc + col0;
#pragma unroll
                for (int bj = 0; bj < 2; ++bj) { acc[ai][bj][m][0] = gelu4(acc[ai][bj][m][0] + b); acc[ai][bj][m][1] = gelu4(acc[ai][bj][m][1] + b);
                    *(u32x4*)(rowp + bj * HALF) = pack8(acc[ai][bj][m][0], acc[ai][bj][m][1]); asm volatile("" ::: "memory"); } }
#pragma unroll
        for (int bj = 0; bj < 2; ++bj)
#pragma unroll
            for (int n = 0; n < 2; ++n) {
                f32x4 s = (f32x4){0.f, 0.f, 0.f, 0.f}, q = (f32x4){0.f, 0.f, 0.f, 0.f};
#pragma unroll
                for (int ai = 0; ai < 2; ++ai)
#pragma unroll
                    for (int m = 0; m < 4; ++m) { const f32x4 v = acc[ai][bj][m][n]; s += v; q += v * v; }
#pragma unroll
                for (int e = 0; e < 4; ++e) {
#pragma unroll
                    for (int o = 1; o < 16; o <<= 1) { s[e] += __shfl_xor(s[e], o); q[e] += __shfl_xor(q[e], o); } }
                if (fr == 0) { float* sp = stats + 2 * (size_t)(col0 + bj * HALF + 4 * n);
#pragma unroll
                    for (int e = 0; e < 4; ++e) { atomicAdd(sp + 2 * e, s[e]); atomicAdd(sp + 2 * e + 1, q[e]); } }
                asm volatile("" ::: "memory");
            }
    }
};
struct EpiSwiglu {
    static constexpr bool PERM = true, AFTER_DRAIN = false;
    bf16_t* O; int ldc;
    __device__ __forceinline__ void operator()(f32x4 (&acc)[2][2][4][2], const Unit& u, int wr, int wc, int fr, int fq) const {
        const int row0 = u.pm * BM + wr * 64 + fr, col0 = u.pn * HALF + wc * 32 + 8 * fq;
#pragma unroll
        for (int ai = 0; ai < 2; ++ai)
#pragma unroll
            for (int m = 0; m < 4; ++m) { bf16_t* rowp = O + (size_t)(row0 + ai * HALF + m * 16) * ldc + col0; f32x4 h[2];
#pragma unroll
                for (int n = 0; n < 2; ++n) { const f32x4 g = acc[ai][0][m][n], up = acc[ai][1][m][n];
#pragma unroll
                    for (int e = 0; e < 4; ++e) { const float sg = __builtin_amdgcn_rcpf(1.f + __builtin_amdgcn_exp2f(-1.4426950408889634f * g[e])); h[n][e] = g[e] * sg * up[e]; } }
                *(u32x4*)rowp = pack8(h[0], h[1]); }
    }
};
struct EpiResF32 {
    static constexpr bool PERM = false, AFTER_DRAIN = false;
    const float* res; float* out; int ldc; float alpha;
    __device__ __forceinline__ void operator()(f32x4 (&acc)[2][2][4][2], const Unit& u, int wr, int wc, int fr, int fq) const {
        const int row0 = u.pm * BM + wr * 64 + fr, col0 = u.pn * BM + wc * 32 + 4 * fq;
#pragma unroll
        for (int ai = 0; ai < 2; ++ai)
#pragma unroll
            for (int m = 0; m < 4; ++m) { const size_t off = (size_t)(row0 + ai * HALF + m * 16) * ldc + col0;
#pragma unroll
                for (int bj = 0; bj < 2; ++bj)
#pragma unroll
                    for (int n = 0; n < 2; ++n) { const f32x4 r = *(const f32x4*)(res + off + bj * HALF + n * 16); *(f32x4*)(out + off + bj * HALF + n * 16) = r * alpha + acc[ai][bj][m][n]; } }
    }
};
template <class Epi, class Sched, bool ALIGN_EPI = false, bool SP2 = false>
__device__ __forceinline__ void gemm_phase(PG8_LAS unsigned char* lds, const Gemm g, const Sched& S, const Epi& E) {
    int tid_ = threadIdx.x; asm volatile("" : "+v"(tid_));
    const int tid = tid_, wid = __builtin_amdgcn_readfirstlane(tid >> 6), lane = tid & 63, wr = wid >> 2, wc = wid & 3, fr = lane & 15, fq = lane >> 4;
    const int K = g.K, nt = K / BK;
    unsigned voffA[2], voffB[2];
#pragma unroll
    for (int i = 0; i < 2; ++i) { int R, C; stage_rc(tid * 16 + i * 8192, R, C); const int Rb = Epi::PERM ? ((R & ~31) + perm32(R & 31)) : R;
        voffA[i] = (unsigned)(R * K + C) * 2u; voffB[i] = (unsigned)(Rb * K + C) * 2u; }
    const size_t kstep = (size_t)(BK * 2);
    const size_t hstep = (size_t)HALF * K * 2;
    const size_t tstep = 2 * hstep;
    const unsigned ldsw = (unsigned)wid * 1024u;
    const int aoff = lds_byte(wr * 64 + fr, fq * 8), boff = lds_byte(wc * 32 + fr, fq * 8);
#define PG8_SA(b, h) (((b) * 2 + (h)) * HTB)
#define PG8_SB(b, h) ((4 + (b) * 2 + (h)) * HTB)
#define PG8_STAGE(bufoff, gbase, voff) do { _Pragma("unroll") for (int _i = 0; _i < 2; ++_i) \
        __builtin_amdgcn_global_load_lds((const unsigned*)((const char*)(gbase) + (voff)[_i]), (PG8_LAS unsigned*)(lds + (bufoff) + ldsw + _i * 8192), 16, 0, 0); } while (0)
#define PG8_LDA(dst, b, h) do { _Pragma("unroll") for (int m = 0; m < 4; ++m) _Pragma("unroll") for (int k = 0; k < 2; ++k) dst[m][k] = *(const PG8_LAS bf16x8*)(lds + PG8_SA(b, h) + aoff + m * 2048 + k * 1024); } while (0)
#define PG8_LDB(dst, b, h) do { _Pragma("unroll") for (int n = 0; n < 2; ++n) _Pragma("unroll") for (int k = 0; k < 2; ++k) dst[n][k] = *(const PG8_LAS bf16x8*)(lds + PG8_SB(b, h) + boff + n * 2048 + k * 1024); } while (0)
#define PG8_MMA(ai, bj, At, Bt) do { __builtin_amdgcn_s_setprio(1); _Pragma("unroll") for (int m = 0; m < 4; ++m) _Pragma("unroll") for (int n = 0; n < 2; ++n) _Pragma("unroll") for (int k = 0; k < 2; ++k) \
        acc[ai][bj][m][n] = __builtin_amdgcn_mfma_f32_16x16x32_bf16(Bt[n][k], At[m][k], acc[ai][bj][m][n], 0, 0, 0); __builtin_amdgcn_s_setprio(0); } while (0)
#define PG8_WAIT_V(n) asm volatile("s_waitcnt vmcnt(" #n ")" ::: "memory")
#define PG8_WAIT_L(n) asm volatile("s_waitcnt lgkmcnt(" #n ")" ::: "memory")
#define PG8_BAR __builtin_amdgcn_s_barrier()
#define PG8_SCHED __builtin_amdgcn_sched_barrier(0)
    Unit cur, nxt; int ui = 0;
    if (!S.next(0, cur)) return;
    f32x4 acc[2][2][4][2];
#pragma unroll
    for (int a = 0; a < 2; ++a)
#pragma unroll
        for (int b = 0; b < 2; ++b)
#pragma unroll
            for (int m = 0; m < 4; ++m)
#pragma unroll
                for (int n = 0; n < 2; ++n) acc[a][b][m][n] = (f32x4){0.f, 0.f, 0.f, 0.f};
    bf16x8 At[4][2], B0[2][2], B1[2][2];
    const char* cA = (const char*)g.A + (size_t)cur.pm * tstep; const char* cB = (const char*)g.Bt + (size_t)cur.pn * tstep;
    S.a_ready(cur);
    if constexpr (SP2) {
        PG8_STAGE(PG8_SB(0, 0), cB, voffB); PG8_STAGE(PG8_SB(0, 1), cB + hstep, voffB); PG8_STAGE(PG8_SA(0, 0), cA, voffA); PG8_STAGE(PG8_SA(0, 1), cA + hstep, voffA);
        if (wr == 1) PG8_BAR;
        PG8_WAIT_V(2); PG8_BAR;
        PG8_STAGE(PG8_SB(1, 0), cB + kstep, voffB); PG8_STAGE(PG8_SA(1, 0), cA + kstep, voffA); PG8_STAGE(PG8_SB(1, 1), cB + hstep + kstep, voffB);
        PG8_WAIT_V(6); PG8_BAR;
    } else {
        PG8_STAGE(PG8_SB(0, 0), cB, voffB); PG8_STAGE(PG8_SA(0, 0), cA, voffA); PG8_STAGE(PG8_SB(0, 1), cB + hstep, voffB); PG8_STAGE(PG8_SA(0, 1), cA + hstep, voffA);
        if (wr == 1) PG8_BAR;
        PG8_WAIT_V(4); PG8_BAR;
        PG8_STAGE(PG8_SB(1, 0), cB + kstep, voffB); PG8_STAGE(PG8_SA(1, 0), cA + kstep, voffA); PG8_STAGE(PG8_SB(1, 1), cB + hstep + kstep, voffB);
        PG8_WAIT_V(6); PG8_BAR;
    }
    for (;;) {
        const bool has_next = S.next(ui + 1, nxt);
        const char* nA = has_next ? (const char*)g.A + (size_t)nxt.pm * tstep : cA; const char* nB = has_next ? (const char*)g.Bt + (size_t)nxt.pn * tstep : cB;
        for (int t = 0; t < nt; t += 2) {
            const bool last = (t == nt - 2);
            const char* a1 = cA + (size_t)(t + 1) * kstep;
            const char* a2 = last ? nA : cA + (size_t)(t + 2) * kstep; const char* b2 = last ? nB : cB + (size_t)(t + 2) * kstep;
            const char* a3 = a2 + kstep; const char* b3 = b2 + kstep;
            if (last && has_next) S.a_ready(nxt);
            if constexpr (SP2) {
            PG8_LDB(B0, 0, 0); PG8_LDB(B1, 0, 1); PG8_SCHED; PG8_LDA(At, 0, 0); PG8_STAGE(PG8_SA(1, 1), a1 + hstep, voffA);
            PG8_WAIT_V(8); PG8_WAIT_L(0); PG8_BAR; PG8_MMA(0, 0, At, B0); PG8_MMA(0, 1, At, B1); PG8_BAR; PG8_SCHED;
            PG8_LDA(At, 0, 1); PG8_STAGE(PG8_SB(0, 0), b2, voffB); PG8_STAGE(PG8_SB(0, 1), b2 + hstep, voffB); PG8_STAGE(PG8_SA(0, 0), a2, voffA);
            PG8_WAIT_V(8); PG8_WAIT_L(0); PG8_BAR; PG8_MMA(1, 0, At, B0); PG8_MMA(1, 1, At, B1); PG8_BAR; PG8_SCHED;
            PG8_LDB(B0, 1, 0); PG8_LDB(B1, 1, 1); PG8_SCHED; PG8_LDA(At, 1, 0); PG8_STAGE(PG8_SA(0, 1), a2 + hstep, voffA);
            PG8_WAIT_V(8); PG8_WAIT_L(0); PG8_BAR; PG8_MMA(0, 0, At, B0); PG8_MMA(0, 1, At, B1); PG8_BAR; PG8_SCHED;
            PG8_LDA(At, 1, 1); PG8_STAGE(PG8_SB(1, 0), b3, voffB); PG8_STAGE(PG8_SB(1, 1), b3 + hstep, voffB); PG8_STAGE(PG8_SA(1, 0), a3, voffA);
            PG8_WAIT_V(8); PG8_WAIT_L(0); PG8_BAR; PG8_MMA(1, 0, At, B0); PG8_MMA(1, 1, At, B1); PG8_BAR; PG8_SCHED;
            } else {
            PG8_LDB(B0, 0, 0); PG8_SCHED; PG8_LDA(At, 0, 0); PG8_STAGE(PG8_SA(1, 1), a1 + hstep, voffA);
            PG8_WAIT_L(8); PG8_BAR; PG8_WAIT_L(0); PG8_MMA(0, 0, At, B0); PG8_BAR; PG8_SCHED;
            PG8_LDB(B1, 0, 1); PG8_STAGE(PG8_SB(0, 0), b2, voffB);
            PG8_BAR; PG8_WAIT_L(0); PG8_MMA(0, 1, At, B1); PG8_BAR;
            PG8_LDA(At, 0, 1); PG8_STAGE(PG8_SA(0, 0), a2, voffA);
            PG8_BAR; PG8_WAIT_L(0); PG8_MMA(1, 0, At, B0); PG8_BAR; PG8_SCHED;
            PG8_STAGE(PG8_SB(0, 1), b2 + hstep, voffB);
            PG8_WAIT_V(6); PG8_BAR; PG8_MMA(1, 1, At, B1); PG8_BAR;
            PG8_LDB(B0, 1, 0); PG8_SCHED; PG8_LDA(At, 1, 0); PG8_STAGE(PG8_SA(0, 1), a2 + hstep, voffA);
            PG8_WAIT_L(8); PG8_BAR; PG8_WAIT_L(0); PG8_MMA(0, 0, At, B0); PG8_BAR; PG8_SCHED;
            PG8_LDB(B1, 1, 1); PG8_STAGE(PG8_SB(1, 0), b3, voffB);
            PG8_BAR; PG8_WAIT_L(0); PG8_MMA(0, 1, At, B1); PG8_BAR;
            PG8_LDA(At, 1, 1); PG8_STAGE(PG8_SA(1, 0), a3, voffA);
            PG8_BAR; PG8_WAIT_L(0); PG8_MMA(1, 0, At, B0); PG8_BAR; PG8_SCHED;
            PG8_STAGE(PG8_SB(1, 1), b3 + hstep, voffB);
            PG8_WAIT_V(6); PG8_BAR; PG8_MMA(1, 1, At, B1); PG8_BAR;
            }
        }
        if constexpr (ALIGN_EPI) { if (wr == 0) PG8_BAR; }
        if constexpr (!Epi::AFTER_DRAIN) { E(acc, cur, wr, wc, fr, fq); S.done(cur); }
        if (!has_next) break;
#pragma unroll
        for (int a = 0; a < 2; ++a)
#pragma unroll
            for (int b = 0; b < 2; ++b)
#pragma unroll
                for (int m = 0; m < 4; ++m)
#pragma unroll
                    for (int n = 0; n < 2; ++n) acc[a][b][m][n] = (f32x4){0.f, 0.f, 0.f, 0.f};
        cur = nxt; cA = nA; cB = nB; ++ui;
        if constexpr (ALIGN_EPI) { if (wr == 1) PG8_BAR; }
    }
    PG8_WAIT_V(0);
    if constexpr (!ALIGN_EPI) { if (wr == 0) PG8_BAR; }
    PG8_BAR;
    if constexpr (Epi::AFTER_DRAIN) { E.fused(acc, cur, wr, wc, fr, fq, lds, wid, lane); S.done(cur); }
#undef PG8_SA
#undef PG8_SB
#undef PG8_STAGE
#undef PG8_LDA
#undef PG8_LDB
#undef PG8_MMA
#undef PG8_WAIT_V
#undef PG8_WAIT_L
#undef PG8_BAR
#undef PG8_SCHED
}
}

#ifndef PROBE_DUP
#define PROBE_DUP 0
#endif
#include <hip/hip_cooperative_groups.h>
namespace cg = cooperative_groups;
#define LAS __attribute__((address_space(3)))
typedef unsigned short bf16;
typedef float f32x4 __attribute__((ext_vector_type(4)));
typedef float f32x16 __attribute__((ext_vector_type(16)));
typedef short bf16x8 __attribute__((ext_vector_type(8)));
typedef unsigned u32x4 __attribute__((ext_vector_type(4)));
typedef unsigned u32x2 __attribute__((ext_vector_type(2)));

constexpr int NWAVES = 8, NTHREADS = 512;
constexpr int DM = 1024, BATCH = 8, SEQ = 2048, MTOK = BATCH * SEQ;
constexpr int NH = 8, DFF = 2816, GHALF = 2048;
constexpr float LN_EPS = 1e-5f;
constexpr float ALPHA = 1.41421356237309515f;
constexpr float LOG2E = 1.4426950408889634f;
constexpr float QSCALE = 0.125f * LOG2E;
constexpr float LAMBDA_INIT = 0.2f;

constexpr size_t MiB = 1u << 20;
constexpr size_t WS_STATS = 0;
constexpr size_t WS_R2 = 512 * 1024;
constexpr size_t WS_BAR = 768 * 1024;
constexpr size_t WS_WSB = 1 * MiB;
constexpr size_t WS_QKT = 2 * MiB, WS_VT_W = 6 * MiB, WS_WOT = 8 * MiB, WS_GUT = 10 * MiB  , WS_DT = 32 * MiB  ;
constexpr size_t WS_WINT = 43 * MiB, WS_WOUTT = 51 * MiB, WS_XB = 55 * MiB, WS_REG = 87 * MiB, WS_END = 215 * MiB;
constexpr size_t GUT_BYTES = 11 * MiB, DT_BYTES = (size_t)1024 * 2816 * 2;
constexpr size_t R_QK = 0, R_VT = 64 * MiB, R_AO = 96 * MiB;
constexpr size_t R_H = 0;
constexpr size_t R_ZU = 0, R_VT2 = 64 * MiB;

constexpr int LDS_BYTES = 147456;

__device__ __forceinline__ unsigned cvtpk(float lo, float hi) { return pg8::cvt_pk_bf16(lo, hi); }
__device__ __forceinline__ float bf2f(unsigned short b) { return __uint_as_float(((unsigned)b) << 16); }
__device__ __forceinline__ float wave_sum(float v) {
#pragma unroll
    for (int o = 1; o < 64; o <<= 1) v += __shfl_xor(v, o);
    return v;
}
#define WG_BAR() do { asm volatile("s_waitcnt vmcnt(0) lgkmcnt(0)" ::: "memory"); __builtin_amdgcn_s_barrier(); asm volatile("" ::: "memory"); } while (0)

__device__ __forceinline__ void tr_item(const float* W, int ldw, bf16* WT, int ldt, int k0, int n0, int drow0, LAS float* scr, int lane) {
#pragma unroll 8
    for (int i = 0; i < 32; ++i) { const int kk = 2 * i + (lane >> 5); scr[kk * 33 + (lane & 31)] = W[(size_t)(k0 + kk) * ldw + n0 + (lane & 31)]; }
    asm volatile("s_waitcnt lgkmcnt(0)" ::: "memory");
    const int c = lane & 7;
#pragma unroll
    for (int j = 0; j < 4; ++j) { const int n = (lane >> 3) + 8 * j; const LAS float* s = scr + (8 * c) * 33 + n;
        u32x4 o; o.x = cvtpk(s[0 * 33], s[1 * 33]); o.y = cvtpk(s[2 * 33], s[3 * 33]); o.z = cvtpk(s[4 * 33], s[5 * 33]); o.w = cvtpk(s[6 * 33], s[7 * 33]);
        *(u32x4*)(WT + (size_t)(drow0 + n) * ldt + k0 + 8 * c) = o; }
    asm volatile("s_waitcnt lgkmcnt(0)" ::: "memory");
}

struct Args {
    const float* in[22]; float* out; unsigned char* ws; int ph_lo, ph_hi;
};
#define CAS __attribute__((address_space(4)))
typedef const CAS Args* ArgsP;
__device__ __forceinline__ ArgsP kargs() { ArgsP p = (ArgsP)__builtin_amdgcn_kernarg_segment_ptr(); asm volatile("" : "+s"(p)); return p; }
enum { I_X = 0, I_WQKV, I_LQ1, I_LK1, I_LQ2, I_LK2, I_SUBG, I_WO, I_GWIN, I_GBIN, I_GLNG, I_GLNB, I_GWS, I_GBS, I_GWOUT, I_LNMG, I_LNMB, I_FG, I_FU, I_FD, I_LNFG, I_LNFB };

__device__ __forceinline__ void prologue(const CAS Args& a, LAS unsigned char* lds, int vcu, int G) {
    int tid_ = threadIdx.x; asm volatile("" : "+v"(tid_));
    const int tid = tid_, lane = tid & 63, wave = __builtin_amdgcn_readfirstlane(tid >> 6);
    unsigned char* ws = a.ws;
    LAS float* scr = (LAS float*)(lds + wave * 16384);
    const int gw = vcu * NWAVES + wave, NGW = G * NWAVES;
    constexpr int IT_QK = 16 * 64, IT_V = 16 * 32, IT_WO = 16 * 32, IT_G = 16 * 88, IT_D = 44 * 32, IT_WIN = 16 * 128, IT_WOUT = 32 * 32;
    constexpr int NITEMS = IT_QK + IT_V + IT_WO + 2 * (2 * IT_G + IT_D) + IT_WIN + IT_WOUT;
    for (int it = gw; it < NITEMS; it += NGW) {
        int r = it;
        if (r < IT_QK) { const int kb = r / 64, nb = r % 64; tr_item(a.in[I_WQKV], 3072, (bf16*)(ws + WS_QKT), 1024, 64 * kb, 32 * nb, 32 * nb, scr, lane); continue; } r -= IT_QK;
        if (r < IT_V) { const int kb = r / 32, nb = r % 32; tr_item(a.in[I_WQKV] + 2048, 3072, (bf16*)(ws + WS_VT_W), 1024, 64 * kb, 32 * nb, 32 * nb, scr, lane); continue; } r -= IT_V;
        if (r < IT_WO) { const int kb = r / 32, nb = r % 32; tr_item(a.in[I_WO], 1024, (bf16*)(ws + WS_WOT), 1024, 64 * kb, 32 * nb, 32 * nb, scr, lane); continue; } r -= IT_WO;
        { constexpr int PER = 2 * IT_G + IT_D;
          if (r < 2 * PER) { const int L = r / PER; const int rr = r % PER;
              if (rr < IT_G) { const int kb = rr / 88, nb = rr % 88, n0 = 32 * nb; tr_item(a.in[I_FG] + (size_t)L * 1024 * 2816, 2816, (bf16*)(ws + WS_GUT + L * GUT_BYTES), 1024, 64 * kb, n0, (n0 >> 7) * 256 + (n0 & 127), scr, lane); }
              else if (rr < 2 * IT_G) { const int r2_ = rr - IT_G; const int kb = r2_ / 88, nb = r2_ % 88, n0 = 32 * nb; tr_item(a.in[I_FU] + (size_t)L * 1024 * 2816, 2816, (bf16*)(ws + WS_GUT + L * GUT_BYTES), 1024, 64 * kb, n0, (n0 >> 7) * 256 + 128 + (n0 & 127), scr, lane); }
              else { const int r3_ = rr - 2 * IT_G; const int kb = r3_ / 32, nb = r3_ % 32; tr_item(a.in[I_FD] + (size_t)L * 2816 * 1024, 1024, (bf16*)(ws + WS_DT + L * DT_BYTES), 2816, 64 * kb, 32 * nb, 32 * nb, scr, lane); }
              continue; }
          r -= 2 * PER; }
        if (r < IT_WIN) { const int kb = r / 128, nb = r % 128; tr_item(a.in[I_GWIN], 4096, (bf16*)(ws + WS_WINT), 1024, 64 * kb, 32 * nb, 32 * nb, scr, lane); continue; } r -= IT_WIN;
        { const int kb = r / 32, nb = r % 32; tr_item(a.in[I_GWOUT], 1024, (bf16*)(ws + WS_WOUTT), 2048, 64 * kb, 32 * nb, 32 * nb, scr, lane); }
    }
    { const float* x = a.in[I_X]; bf16* xb = (bf16*)(ws + WS_XB); const size_t n8 = (size_t)MTOK * DM / 8;
      for (size_t i = (size_t)vcu * NTHREADS + tid; i < n8; i += (size_t)G * NTHREADS) { const f32x4 v0 = *(const f32x4*)(x + 8 * i), v1 = *(const f32x4*)(x + 8 * i + 4); *(u32x4*)(xb + 8 * i) = pg8::pack8(v0, v1); } }
    { const float* wsrc = a.in[I_GWS]; bf16* wsb = (bf16*)(ws + WS_WSB); float* r2 = (float*)(ws + WS_R2);
      for (int row = gw; row < 8 * 128; row += NGW) { const int t = row & 127; float s = 0.f;
#pragma unroll
          for (int j = 0; j < 2; ++j) { const int sidx = lane + 64 * j; float w = wsrc[(size_t)row * 128 + sidx]; if (sidx > t) w = 0.f; const unsigned b = cvtpk(w, 0.f) & 0xffffu; wsb[(size_t)row * 128 + sidx] = (bf16)b; s += bf2f((unsigned short)b); }
          s = wave_sum(s); if (lane == 0) r2[row] = s; }
      float* st = (float*)(ws + WS_STATS);
      for (int i = vcu * NTHREADS + tid; i < MTOK * 2; i += G * NTHREADS) st[i] = 0.f; }
}

__device__ __forceinline__ void ln_rows(const float* src, const float* gamma, const float* beta, float* outf, bf16* outb, int vcu, int G, int rowmask = 0x7fffffff) {
    int tid_ = threadIdx.x; asm volatile("" : "+v"(tid_));
    const int tid = tid_, lane = tid & 63, wave = __builtin_amdgcn_readfirstlane(tid >> 6);
    const int gw = vcu * NWAVES + wave, NGW = G * NWAVES;
    f32x4 gm[4], bt[4];
#pragma unroll
    for (int j = 0; j < 4; ++j) { gm[j] = *(const f32x4*)(gamma + 4 * lane + 256 * j); bt[j] = *(const f32x4*)(beta + 4 * lane + 256 * j); }
    for (int m = gw; m < MTOK; m += NGW) {
        const f32x4* xr = (const f32x4*)(src + (size_t)m * DM) + lane;
        f32x4 v[4]; float s = 0.f;
#pragma unroll
        for (int j = 0; j < 4; ++j) { v[j] = xr[64 * j]; s += (v[j].x + v[j].y) + (v[j].z + v[j].w); }
        const float mean = wave_sum(s) * (1.f / DM); float s2 = 0.f;
#pragma unroll
        for (int j = 0; j < 4; ++j) { v[j] = v[j] - mean; s2 += (v[j].x * v[j].x + v[j].y * v[j].y) + (v[j].z * v[j].z + v[j].w * v[j].w); }
        const float rstd = 1.f / sqrtf(wave_sum(s2) * (1.f / DM) + LN_EPS);
#pragma unroll
        for (int j = 0; j < 4; ++j) { v[j] = v[j] * rstd * gm[j] + bt[j]; }
        f32x4* of = (f32x4*)(outf + (size_t)(m & rowmask) * DM) + lane;
#pragma unroll
        for (int j = 0; j < 4; ++j) of[64 * j] = v[j];
        if (outb) { u32x2* ob = (u32x2*)(outb + (size_t)(m & rowmask) * DM) + lane;
#pragma unroll
            for (int j = 0; j < 4; ++j) { u32x2 w; w.x = cvtpk(v[j].x, v[j].y); w.y = cvtpk(v[j].z, v[j].w); ob[64 * j] = w; } }
    }
}

namespace att {
constexpr int KROW = 272, VROW = 144, KBUF = 64 * KROW, VBUF = 128 * VROW, STG = KBUF + VBUF;
__device__ __forceinline__ int pi5(int k) { return (k & ~12) | ((k & 4) << 1) | ((k & 8) >> 1); }

__device__ __forceinline__ void unit(LAS unsigned char* lds, const bf16* QK, const bf16* VT, bf16* AO, const float* gsub, int b, int h, int qb, float lam) {
    int tid_ = threadIdx.x; asm volatile("" : "+v"(tid_));
    const int tid = tid_, lane = tid & 63, r32 = lane & 31, hi = lane >> 5, wid = __builtin_amdgcn_readfirstlane(tid >> 6);
    const int rg = wid & 3, c = wid >> 2;
    const int q0 = qb * 128 + rg * 32, mychunk = q0 >> 6, NT = 2 * qb + 2;
    const size_t tokbase = (size_t)b * SEQ;
    const float slope2 = LOG2E * __builtin_amdgcn_exp2f(-(float)(h + 1));
    bf16x8 qf[4];
    { const bf16* qp = QK + (tokbase + q0 + r32) * 2048 + h * 128 + c * 64 + hi * 8;
#pragma unroll
      for (int d0 = 0; d0 < 4; ++d0) qf[d0] = *(const bf16x8*)(qp + d0 * 16); }
    const bf16* ksrc[2]; const bf16* vsrc[2]; int kdst[2], vdst[2];
#pragma unroll
    for (int i = 0; i < 2; ++i) { const int idx = tid + NTHREADS * i; const int key = idx >> 4, ch = idx & 15;
        ksrc[i] = QK + (tokbase + key) * 2048 + 1024 + h * 128 + ch * 8; kdst[i] = pi5(key) * KROW + ch * 16;
        const int d = idx >> 3, cv = idx & 7;
        vsrc[i] = VT + (size_t)(h * 128 + d) * MTOK + tokbase + cv * 8; vdst[i] = KBUF + d * VROW + cv * 16; }
    u32x4 kreg[2], vreg[2];
#define ATT_LOAD(t) do { _Pragma("unroll") for (int i = 0; i < 2; ++i) { kreg[i] = *(const u32x4*)(ksrc[i] + (size_t)(t) * 64 * 2048); vreg[i] = *(const u32x4*)(vsrc[i] + (t) * 64); } } while (0)
#define ATT_STORE(s) do { _Pragma("unroll") for (int i = 0; i < 2; ++i) { *(LAS u32x4*)(lds + (s) * STG + kdst[i]) = kreg[i]; *(LAS u32x4*)(lds + (s) * STG + vdst[i]) = vreg[i]; } } while (0)
    ATT_LOAD(0); ATT_STORE(0); WG_BAR();
    f32x16 o[4];
#pragma unroll
    for (int d = 0; d < 4; ++d)
#pragma unroll
        for (int r = 0; r < 16; ++r) o[d][r] = 0.f;
    float m_run = -1e30f, l_run = 0.f;
    const float qposf = (float)(q0 + r32);
    for (int t = 0; t < NT; ++t) {
        if (t + 1 < NT) ATT_LOAD(t + 1);
        if (t <= mychunk) {
            const LAS unsigned char* Kb = lds + (t & 1) * STG + c * 128 + r32 * KROW + hi * 16;
            const LAS unsigned char* Vb = lds + (t & 1) * STG + KBUF + r32 * VROW + hi * 16;
            f32x16 p0, p1;
#pragma unroll
            for (int r = 0; r < 16; ++r) { p0[r] = 0.f; p1[r] = 0.f; }
#pragma unroll
            for (int d0 = 0; d0 < 4; ++d0) {
                const bf16x8 a0 = *(const LAS bf16x8*)(Kb + d0 * 32), a1 = *(const LAS bf16x8*)(Kb + 32 * KROW + d0 * 32);
                p0 = __builtin_amdgcn_mfma_f32_32x32x16_bf16(a0, qf[d0], p0, 0, 0, 0);
                p1 = __builtin_amdgcn_mfma_f32_32x32x16_bf16(a1, qf[d0], p1, 0, 0, 0);
            }
            const float dq = qposf - (float)(64 * t + 8 * hi);
            float mx = -1e30f;
#pragma unroll
            for (int r = 0; r < 16; ++r) { const float kk = (float)(16 * (r >> 3) + (r & 7));
                p0[r] = __builtin_fmaf(-slope2, __builtin_fabsf(dq - kk), p0[r]); p1[r] = __builtin_fmaf(-slope2, __builtin_fabsf(dq - kk - 32.f), p1[r]);
                mx = __builtin_fmaxf(mx, __builtin_fmaxf(p0[r], p1[r])); }
            mx = __builtin_fmaxf(mx, __shfl_xor(mx, 32));
            const float mnew = __builtin_fmaxf(m_run, mx), f = __builtin_amdgcn_exp2f(m_run - mnew);
            m_run = mnew; l_run *= f;
#pragma unroll
            for (int d = 0; d < 4; ++d)
#pragma unroll
                for (int r = 0; r < 16; ++r) o[d][r] *= f;
            float ps = 0.f;
#pragma unroll
            for (int r = 0; r < 16; ++r) { p0[r] = __builtin_amdgcn_exp2f(p0[r] - mnew); p1[r] = __builtin_amdgcn_exp2f(p1[r] - mnew); ps += p0[r] + p1[r]; }
            l_run += ps;
            u32x4 pk[4];
#pragma unroll
            for (int j = 0; j < 4; ++j) { pk[0][j] = cvtpk(p0[2 * j], p0[2 * j + 1]); pk[1][j] = cvtpk(p0[8 + 2 * j], p0[9 + 2 * j]); pk[2][j] = cvtpk(p1[2 * j], p1[2 * j + 1]); pk[3][j] = cvtpk(p1[8 + 2 * j], p1[9 + 2 * j]); }
#pragma unroll
            for (int d = 0; d < 4; ++d)
#pragma unroll
                for (int ks = 0; ks < 4; ++ks) {
                    const bf16x8 vf = *(const LAS bf16x8*)(Vb + d * 32 * VROW + ks * 32);
                    o[d] = __builtin_amdgcn_mfma_f32_32x32x16_bf16(vf, __builtin_bit_cast(bf16x8, pk[ks]), o[d], 0, 0, 0);
                }
        }
        if (t + 1 < NT) ATT_STORE((t + 1) & 1);
        WG_BAR();
    }
#undef ATT_LOAD
#undef ATT_STORE
    const float linv = 1.f / (l_run + __shfl_xor(l_run, 32));
    LAS float* comb = (LAS float*)lds + rg * 4096 + lane;
    if (c == 1) {
#pragma unroll
        for (int d = 0; d < 4; ++d)
#pragma unroll
            for (int r = 0; r < 16; ++r) comb[(d * 16 + r) * 64] = o[d][r] * linv;
    }
    WG_BAR();
    if (c == 0) {
        float ss = 0.f;
#pragma unroll
        for (int d = 0; d < 4; ++d)
#pragma unroll
            for (int r = 0; r < 16; ++r) { const float v = o[d][r] * linv - lam * comb[(d * 16 + r) * 64]; o[d][r] = v; ss += v * v; }
        ss += __shfl_xor(ss, 32);
        const float rs = (1.f - LAMBDA_INIT) / sqrtf(ss * (1.f / 128.f) + LN_EPS);
        bf16* op = AO + (tokbase + q0 + r32) * 1024 + h * 128 + 4 * hi;
#pragma unroll
        for (int d = 0; d < 4; ++d)
#pragma unroll
            for (int g4 = 0; g4 < 4; ++g4) { const int dd = 32 * d + 8 * g4; const f32x4 gs = *(const f32x4*)(gsub + dd + 4 * hi);
                u32x2 w; w.x = cvtpk(o[d][4 * g4] * rs * gs[0], o[d][4 * g4 + 1] * rs * gs[1]); w.y = cvtpk(o[d][4 * g4 + 2] * rs * gs[2], o[d][4 * g4 + 3] * rs * gs[3]);
                *(u32x2*)(op + dd) = w; }
    }
    WG_BAR();
}

__device__ __forceinline__ void phase(LAS unsigned char* lds, const CAS Args& a, int vcu, int G) {
    const bf16* QK = (const bf16*)(a.ws + WS_REG + R_QK); const bf16* VT = (const bf16*)(a.ws + WS_REG + R_VT); bf16* AO = (bf16*)(a.ws + WS_REG + R_AO);
    float d1 = 0.f, d2 = 0.f;
    for (int i = 0; i < 64; ++i) { d1 += a.in[I_LQ1][i] * a.in[I_LK1][i]; d2 += a.in[I_LQ2][i] * a.in[I_LK2][i]; }
    const float lam = __expf(d1) - __expf(d2) + LAMBDA_INIT;
    for (int w = vcu; w < 256; w += G) {
        const int bh = w >> 2, j = w & 3, b = bh >> 3, h = bh & 7;
#pragma unroll 1
        for (int i = 0; i < 4; ++i) { const int qb = (i == 0) ? j : (i == 1) ? 15 - j : (i == 2) ? j + 4 : 11 - j; unit(lds, QK, VT, AO, a.in[I_SUBG], b, h, qb, lam); }
    }
}
}

namespace gat {
constexpr int ROWB = 272;
constexpr int L_VT = 0, L_W = 256 * ROWB, L_MEAN = L_W + 128 * ROWB, L_RSTD = L_MEAN + 512, L_R1 = L_RSTD + 512, L_END = L_R1 + 512;
static_assert(L_END <= 131072, "gating LDS");
__device__ __forceinline__ void unit(LAS unsigned char* lds, const CAS Args& a, int n, int g, bool dummy = false) {
    int tid_ = threadIdx.x; asm volatile("" : "+v"(tid_));
    const int tid = tid_, lane = tid & 63, r32 = lane & 31, hi = lane >> 5, wid = __builtin_amdgcn_readfirstlane(tid >> 6);
    unsigned char* ws = a.ws;
    const bf16* VT2 = (const bf16*)(ws + WS_REG + R_VT2); bf16* ZU = (bf16*)(ws + WS_REG + R_ZU);
    const float* stats = (const float*)(ws + WS_STATS); const bf16* wsb = (const bf16*)(ws + WS_WSB) + (size_t)g * 128 * 128; const float* r2 = (const float*)(ws + WS_R2) + g * 128;
    LAS float* Lmean = (LAS float*)(lds + L_MEAN); LAS float* Lrstd = (LAS float*)(lds + L_RSTD); LAS float* Lr1 = (LAS float*)(lds + L_R1);
    if (tid < 128) { const float s = stats[2 * (n * 128 + tid)], q = stats[2 * (n * 128 + tid) + 1]; const float mean = s * (1.f / GHALF); const float var = __builtin_fmaxf(q * (1.f / GHALF) - mean * mean, 0.f);
        Lmean[tid] = mean; Lrstd[tid] = 1.f / sqrtf(var + LN_EPS); }
#pragma unroll
    for (int i = 0; i < 8; ++i) { const int idx = tid + NTHREADS * i, c = idx >> 4, ch = idx & 15;
        const u32x4 v = *(const u32x4*)(VT2 + (size_t)(g * 256 + c) * MTOK + n * 128 + ch * 8); *(LAS u32x4*)(lds + L_VT + c * ROWB + ch * 16) = v; }
    WG_BAR();
#pragma unroll
    for (int i = 0; i < 4; ++i) { const int idx = tid + NTHREADS * i, t = idx >> 4, ch = idx & 15;
        const u32x4 v = *(const u32x4*)(wsb + t * 128 + ch * 8); u32x4 w;
#pragma unroll
        for (int e = 0; e < 4; ++e) { const float lo = __uint_as_float(v[e] << 16) * Lrstd[ch * 8 + 2 * e], hh = __uint_as_float(v[e] & 0xffff0000u) * Lrstd[ch * 8 + 2 * e + 1]; w[e] = cvtpk(lo, hh); }
        *(LAS u32x4*)(lds + L_W + t * ROWB + ch * 16) = w; }
    WG_BAR();
    if (tid < 128) { const LAS unsigned short* wr_ = (const LAS unsigned short*)(lds + L_W + tid * ROWB); float s = 0.f;
        for (int k = 0; k < 128; ++k) s += bf2f(wr_[k]) * Lmean[k];
        Lr1[tid] = s; }
    f32x16 acc[4];
#pragma unroll
    for (int tb = 0; tb < 4; ++tb)
#pragma unroll
        for (int r = 0; r < 16; ++r) acc[tb][r] = 0.f;
    { const LAS unsigned char* Ab = lds + L_VT + (32 * wid + r32) * ROWB + hi * 16; const LAS unsigned char* Bb = lds + L_W + r32 * ROWB + hi * 16;
#pragma unroll
      for (int ks = 0; ks < 8; ++ks) { const bf16x8 af = *(const LAS bf16x8*)(Ab + ks * 32);
#pragma unroll
          for (int tb = 0; tb < 4; ++tb) if (2 * tb + 1 >= ks) { const bf16x8 bfr = *(const LAS bf16x8*)(Bb + tb * 32 * ROWB + ks * 32); acc[tb] = __builtin_amdgcn_mfma_f32_32x32x16_bf16(af, bfr, acc[tb], 0, 0, 0); } } }
    WG_BAR();
    const float* lng = a.in[I_GLNG] + g * 256 + 32 * wid + 4 * hi; const float* lnb = a.in[I_GLNB] + g * 256 + 32 * wid + 4 * hi;
    f32x4 gm[4], bt[4];
#pragma unroll
    for (int g4 = 0; g4 < 4; ++g4) { gm[g4] = *(const f32x4*)(lng + 8 * g4); bt[g4] = *(const f32x4*)(lnb + 8 * g4); }
#pragma unroll
    for (int tb = 0; tb < 4; ++tb) { const int t = 32 * tb + r32; const float r1 = Lr1[t], r2t = r2[t], bs = a.in[I_GBS][g * 128 + t];
        bf16* up = ZU + (size_t)(n * 128 + t) * GHALF + g * 256 + 32 * wid + 4 * hi;
        bf16* yp = dummy ? (bf16*)(ws + WS_END) + (size_t)((n & 63) * 128 + t) * GHALF + g * 256 + 32 * wid + 4 * hi : up;
#pragma unroll
        for (int g4 = 0; g4 < 4; ++g4) { const u32x2 uv = *(const u32x2*)(up + 8 * g4); float o4[4];
#pragma unroll
            for (int e = 0; e < 4; ++e) o4[e] = gm[g4][e] * (acc[tb][4 * g4 + e] - r1) + bt[g4][e] * r2t + bs;
            u32x2 w; w.x = cvtpk(__uint_as_float(uv.x << 16) * o4[0], __uint_as_float(uv.x & 0xffff0000u) * o4[1]); w.y = cvtpk(__uint_as_float(uv.y << 16) * o4[2], __uint_as_float(uv.y & 0xffff0000u) * o4[3]);
            *(u32x2*)(yp + 8 * g4) = w; } }
    WG_BAR();
}
__device__ __forceinline__ void phase(LAS unsigned char* lds, const CAS Args& a, int vcu, int G, bool dummy = false) {
    for (int w = vcu; w < 1024; w += G) unit(lds, a, w >> 3, w & 7, dummy);
}
}

#define XB_TMO      128
#define XB_XCNT(j)  (256  + 64 * (j))
#define XB_XSUB(j)  (1280 + 64 * (j))
#define XB_XGEN(j)  (2304 + 64 * (j))
#define XB_TOP      3328
#define XB_TOPGEN   3392
#define XCD_BAR_WORDS 3456
#define XB_SPIN_CAP (1u << 18)

__device__ __forceinline__ unsigned xb_ld(unsigned* p)              { return __hip_atomic_load(p, __ATOMIC_RELAXED, __HIP_MEMORY_SCOPE_AGENT); }
__device__ __forceinline__ unsigned xb_add(unsigned* p, unsigned v) { return __hip_atomic_fetch_add(p, v, __ATOMIC_RELAXED, __HIP_MEMORY_SCOPE_AGENT); }
__device__ __forceinline__ unsigned xb_xcc_id() { return (unsigned)__builtin_amdgcn_s_getreg((3 << 11) | 20) & 0xFu; }
#define XB_SPIN(cond, bar) do { unsigned _sp = 0; while (cond) { __builtin_amdgcn_s_sleep(1); \
    if ((++_sp & 255u) == 0u) { if (xb_ld(&(bar)[XB_TMO])) break; if (_sp > XB_SPIN_CAP) { atomicAdd(&(bar)[XB_TMO], 1u); break; } } } } while (0)

struct XcdBarrier {
    unsigned* bar; unsigned x;
    volatile LAS unsigned* st;
};

__device__ __forceinline__ XcdBarrier xcd_barrier_post(unsigned* bar, volatile LAS unsigned* st) {
    XcdBarrier b; b.bar = bar; b.x = xb_xcc_id(); b.st = st;
    if (threadIdx.x == 0) (void)xb_add(&bar[XB_XCNT(b.x)], 1u);
    return b;
}
__device__ __forceinline__ void xcd_barrier_complete(unsigned* bar, unsigned x, unsigned& nloc, unsigned& nx) {
    const unsigned G = gridDim.x * gridDim.y * gridDim.z;
    unsigned sum, cnt, mine, sp = 0u;
    for (;;) {
        sum = 0u; cnt = 0u; mine = 0u;
#pragma unroll
        for (unsigned j = 0; j < 16; ++j) { const unsigned c = xb_ld(&bar[XB_XCNT(j)]); sum += c; cnt += (c > 0u) ? 1u : 0u; mine = (j == x) ? c : mine; }
        if (sum == G) break;
        __builtin_amdgcn_s_sleep(1);
        if ((++sp & 255u) == 0u) { if (xb_ld(&bar[XB_TMO])) break; if (sp > XB_SPIN_CAP) { atomicAdd(&bar[XB_TMO], 1u); break; } }
    }
    nloc = mine > 0u ? mine : 1u; nx = cnt > 0u ? cnt : 1u;
}

__device__ __forceinline__ void xcd_barrier(const XcdBarrier& b) {
    asm volatile("s_waitcnt vmcnt(0)" ::: "memory");
    __syncthreads();
    if (threadIdx.x == 0) {
        unsigned* bar = b.bar;
        __builtin_amdgcn_s_waitcnt(0);
        unsigned nloc = b.st[0], nx = b.st[1];
        if (nloc == 0u) { xcd_barrier_complete(bar, b.x, nloc, nx); b.st[0] = nloc; b.st[1] = nx; }
        const unsigned old = xb_add(&bar[XB_XSUB(b.x)], 1u);
        const unsigned gen = old / nloc;
        if (old + 1u == (gen + 1u) * nloc) {
            __builtin_amdgcn_fence(__ATOMIC_RELEASE, "agent");
            asm volatile("s_waitcnt vmcnt(0)" ::: "memory");
            const unsigned og = xb_add(&bar[XB_TOP], 1u);
            const unsigned tg = og / nx;
            if (og + 1u == (tg + 1u) * nx) xb_add(&bar[XB_TOPGEN], 1u);
            else XB_SPIN(xb_ld(&bar[XB_TOPGEN]) == tg, bar);
            __builtin_amdgcn_fence(__ATOMIC_ACQUIRE, "agent");
            xb_add(&bar[XB_XGEN(b.x)], 1u);
            asm volatile("s_waitcnt vmcnt(0)" ::: "memory");
        } else {
            XB_SPIN(xb_ld(&bar[XB_XGEN(b.x)]) == gen, bar);
            __builtin_amdgcn_fence(__ATOMIC_ACQUIRE, "agent");
            asm volatile("s_waitcnt vmcnt(0)" ::: "memory");
        }
    }
    __syncthreads();
}
__global__ void __launch_bounds__(NTHREADS, 2) fwd_kernel(Args args_unused) {
    extern __shared__ __attribute__((aligned(16))) unsigned char lds_raw[];
    LAS unsigned char* lds = (LAS unsigned char*)lds_raw;
    cg::grid_group grid = cg::this_grid();
    const int G = gridDim.x, bx = blockIdx.x;
    const int vcu = (G % 8 == 0) ? (bx % 8) * (G / 8) + bx / 8 : bx;
    int lo, hi; { ArgsP kp = kargs(); lo = kp->ph_lo; hi = kp->ph_hi; }
    int ph = 0;
    volatile LAS unsigned* bst = (volatile LAS unsigned*)(lds + 131072 + 256);
    if (threadIdx.x < 2) bst[threadIdx.x] = 0u;
    __syncthreads();
    XcdBarrier xbar; { ArgsP kp = kargs(); xbar = xcd_barrier_post((unsigned*)(kp->ws + WS_BAR), bst); }
    if (hi > 1000) grid.sync();
#define PHASE_BEGIN if (ph >= lo && ph < hi) { const CAS Args& A = *kargs(); unsigned char* ws = A.ws; bf16* XB = (bf16*)(ws + WS_XB); float* X = A.out; (void)XB; (void)X;
#define PHASE_END   if (ph + 1 < hi) xcd_barrier(xbar); } ++ph;

#if PROBE_DUP & 32
    for (int i_ = 0; i_ < 10; ++i_) xcd_barrier(xbar);
#endif
    PHASE_BEGIN prologue(A, lds, vcu, G);
#if PROBE_DUP & 2
 prologue(A, lds, vcu, G);
#endif
 PHASE_END

    PHASE_BEGIN
    { pg8::Gemm g{XB, (const bf16*)(ws + WS_QKT), MTOK, 2048, DM}; pg8::StaticOrder S; S.init(MTOK, 2048, G, bx);
      pg8::EpiScaleBf16 E{(bf16*)(ws + WS_REG + R_QK), 2048, 4, QSCALE};
      pg8::gemm_phase<pg8::EpiScaleBf16, pg8::StaticOrder, true, true>(lds, g, S, E); }
    { pg8::Gemm g{(const bf16*)(ws + WS_VT_W), XB, DM, MTOK, DM}; pg8::StaticOrder S; S.init(DM, MTOK, G, bx);
      pg8::EpiScaleBf16 E{(bf16*)(ws + WS_REG + R_VT), MTOK, 0, 1.f};
      pg8::gemm_phase<pg8::EpiScaleBf16, pg8::StaticOrder, true, true>(lds, g, S, E); }
    PHASE_END

    PHASE_BEGIN att::phase(lds, A, vcu, G);
#if PROBE_DUP & 1
 att::phase(lds, A, vcu, G);
#endif
 PHASE_END

    PHASE_BEGIN
    { pg8::Gemm g{(const bf16*)(ws + WS_REG + R_AO), (const bf16*)(ws + WS_WOT), MTOK, DM, DM}; pg8::StaticOrder S; S.init(MTOK, DM, G, bx);
      pg8::EpiResF32 E{A.in[I_X], X, DM, ALPHA};
      pg8::gemm_phase<pg8::EpiResF32, pg8::StaticOrder, true, true>(lds, g, S, E); }
    PHASE_END
    PHASE_BEGIN
#if PROBE_DUP & 16
 ln_rows(X, A.in[I_LNMG], A.in[I_LNMB], (float*)(ws + WS_END), (bf16*)(ws + WS_END + 16 * MiB), vcu, G, 4095);
#endif
 ln_rows(X, A.in[I_LNMG], A.in[I_LNMB], X, XB, vcu, G); PHASE_END

#pragma unroll 1
    for (int L = 0; L < 2; ++L) {
        if (L == 1) {
            PHASE_BEGIN
            { pg8::Gemm g{XB, (const bf16*)(ws + WS_WINT), MTOK, GHALF, DM}; pg8::StaticOrder S; S.init(MTOK, GHALF, G, bx);
              pg8::EpiGeluColBias E{(bf16*)(ws + WS_REG + R_ZU), GHALF, A.in[I_GBIN]};
              pg8::gemm_phase<pg8::EpiGeluColBias, pg8::StaticOrder, true, true>(lds, g, S, E); }
            PHASE_END
            PHASE_BEGIN
            { pg8::Gemm g{(const bf16*)(ws + WS_WINT) + (size_t)GHALF * DM, XB, GHALF, MTOK, DM}; pg8::StaticOrder S; S.init(GHALF, MTOK, G, bx);
              pg8::EpiGeluRowBiasStats E{(bf16*)(ws + WS_REG + R_VT2), MTOK, A.in[I_GBIN] + GHALF, (float*)(ws + WS_STATS)};
              pg8::gemm_phase<pg8::EpiGeluRowBiasStats, pg8::StaticOrder, true, true>(lds, g, S, E); }
            PHASE_END
            PHASE_BEGIN
#if PROBE_DUP & 4
 gat::phase(lds, A, vcu, G, true);
#endif
 gat::phase(lds, A, vcu, G); PHASE_END
            PHASE_BEGIN
            { pg8::Gemm g{(const bf16*)(ws + WS_REG + R_ZU), (const bf16*)(ws + WS_WOUTT), MTOK, DM, GHALF}; pg8::StaticOrder S; S.init(MTOK, DM, G, bx);
              pg8::EpiResF32 E{X, X, DM, ALPHA};
              pg8::gemm_phase<pg8::EpiResF32, pg8::StaticOrder, true, true>(lds, g, S, E); }
            PHASE_END
            PHASE_BEGIN ln_rows(X, A.in[I_LNMG] + DM, A.in[I_LNMB] + DM, X, XB, vcu, G); PHASE_END
        }
        PHASE_BEGIN
        { pg8::Gemm g{XB, (const bf16*)(ws + WS_GUT + L * GUT_BYTES), MTOK, 2 * DFF, DM}; pg8::StaticOrder S; S.init(MTOK, 2 * DFF, G, bx);
          pg8::EpiSwiglu E{(bf16*)(ws + WS_REG + R_H), DFF};
          pg8::gemm_phase<pg8::EpiSwiglu, pg8::StaticOrder, true, true>(lds, g, S, E);
#if PROBE_DUP & 8
          pg8::gemm_phase<pg8::EpiSwiglu, pg8::StaticOrder, true, true>(lds, g, S, E);
#endif
        }
        PHASE_END
        PHASE_BEGIN
        { pg8::Gemm g{(const bf16*)(ws + WS_REG + R_H), (const bf16*)(ws + WS_DT + L * DT_BYTES), MTOK, DM, DFF}; pg8::StaticOrder S; S.init(MTOK, DM, G, bx);
          pg8::EpiResF32 E{X, X, DM, ALPHA};
          pg8::gemm_phase<pg8::EpiResF32, pg8::StaticOrder, true, true>(lds, g, S, E); }
        PHASE_END
        PHASE_BEGIN ln_rows(X, A.in[I_LNFG] + L * DM, A.in[I_LNFB] + L * DM, X, (L == 0) ? XB : (bf16*)nullptr, vcu, G); PHASE_END
    }
#undef PHASE_BEGIN
#undef PHASE_END
}
constexpr int N_PHASES = 5 + 3 + 5 + 3;

#ifndef PROBE_DUP
#define PROBE_DUP 0
#endif
#ifndef MK_PER_PHASE
#define MK_PER_PHASE 0
#endif

extern "C" void kernel_launch(void* const* d_in, const int* in_sizes, int n_in, void* d_out, int out_size, void* d_ws, size_t ws_size, hipStream_t stream) {
    static int grid = 0;
    if (grid == 0) {
        int dev = 0, cus = 0, per_cu = 0;
        hipGetDevice(&dev); hipDeviceGetAttribute(&cus, hipDeviceAttributeMultiprocessorCount, dev);
        hipFuncSetAttribute((const void*)fwd_kernel, hipFuncAttributeMaxDynamicSharedMemorySize, LDS_BYTES);
        if (hipOccupancyMaxActiveBlocksPerMultiprocessor(&per_cu, (const void*)fwd_kernel, NTHREADS, LDS_BYTES) != hipSuccess || per_cu < 1) { fprintf(stderr, "occupancy query: %d\n", per_cu); per_cu = 1; }
        (void)hipGetLastError();
        grid = cus * 1;
        if (n_in != 22 || ws_size < WS_END) { fprintf(stderr, "kernel_launch: unexpected n_in %d / ws %zu\n", n_in, ws_size); }
    }
    Args a{};
    for (int i = 0; i < 22; ++i) a.in[i] = (const float*)d_in[i];
    a.out = (float*)d_out; a.ws = (unsigned char*)d_ws;
    if (hipMemsetAsync((char*)d_ws + WS_BAR, 0, 16384, stream) != hipSuccess) fprintf(stderr, "memset failed\n");
#if MK_PER_PHASE
    for (int p = 0; p < N_PHASES; ++p) { a.ph_lo = p; a.ph_hi = p + 1; hipLaunchKernelGGL(fwd_kernel, dim3(grid), dim3(NTHREADS), LDS_BYTES, stream, a); }
#else
    a.ph_lo = 0; a.ph_hi = N_PHASES;
    void* kargs[] = {&a};
    hipError_t e = hipLaunchCooperativeKernel((const void*)fwd_kernel, dim3(grid), dim3(NTHREADS), kargs, LDS_BYTES, stream);
    if (e != hipSuccess) fprintf(stderr, "cooperative launch failed: %s (grid %d)\n", hipGetErrorString(e), grid);
#endif
}
```
